# Optimizing an MI355X kernel written in HIP

```python
import jax, jax.numpy as jnp
from jax import lax
import numpy as np

D_MODEL = 4096
BATCH = 4
SEQ = 2048
DEPTH = 1
DEC_BATCH = 8
DEC_SEQ = 32
PAST_LEN = 1024

CHUNK = 64
N_META = 16
EPS = 1e-6
V_HEAD = 128
QK_NOPE = 128
QK_ROPE = 64
Q_LORA = 1536
KV_LORA = 512
MLA_HEADS = (D_MODEL // 2) // V_HEAD
MLA_WIDTH = MLA_HEADS * V_HEAD
ATTN_SCALE = (QK_NOPE + QK_ROPE) ** -0.5
ROPE_THETA = 10000.0
Q_BLOCK = 128
ML_DV = 512
ML_DQK = 256
ML_HEADS = (D_MODEL // 2) // ML_DV
ML_WIDTH = ML_HEADS * ML_DV
ML_BLOCK = 16
D_MIX = MLA_WIDTH + ML_WIDTH
OFF_CQ = 0
OFF_CKV = OFF_CQ + Q_LORA
OFF_KPE = OFF_CKV + KV_LORA
OFF_MQ = OFF_KPE + QK_ROPE
OFF_MK = OFF_MQ + ML_HEADS * ML_DQK
OFF_MV = OFF_MK + ML_HEADS * ML_DQK
OFF_MO = OFF_MV + ML_WIDTH
OFF_MI = OFF_MO + ML_WIDTH
OFF_MF = OFF_MI + ML_HEADS
OFF_ZA = OFF_MF + ML_HEADS
OFF_ZB = OFF_ZA + MLA_WIDTH
IN_COLS = OFF_ZB + ML_WIDTH

kernel_name = 'hymba_mla_mlstm_streaming_step'


def rmsnorm(x, g):
    xf = x.astype(jnp.float32)
    y = xf * lax.rsqrt(jnp.mean(xf * xf, axis=-1, keepdims=True) + EPS)
    return (y * g.astype(jnp.float32)).astype(x.dtype)


def rope(x, pos):
    half = QK_ROPE // 2
    inv_freq = ROPE_THETA ** (-jnp.arange(half, dtype=jnp.float32) / half)
    ang = pos.astype(jnp.float32)[:, None] * inv_freq[None, :]
    cos = jnp.cos(ang)[None, :, None, :]
    sin = jnp.sin(ang)[None, :, None, :]
    xf = x.astype(jnp.float32)
    x1, x2 = xf[..., :half], xf[..., half:]
    return jnp.concatenate([x1 * cos - x2 * sin, x2 * cos + x1 * sin], axis=-1).astype(x.dtype)


def chunk_id(p):
    return jnp.where(p < N_META, 0, (p - N_META) // CHUNK + 1)


def project(h, w_in):
    p = h @ w_in
    return (p[..., OFF_CQ:OFF_CKV], p[..., OFF_CKV:OFF_KPE], p[..., OFF_KPE:OFF_MQ],
            p[..., OFF_MQ:OFF_MK], p[..., OFF_MK:OFF_MV], p[..., OFF_MV:OFF_MO],
            p[..., OFF_MO:OFF_MI], p[..., OFF_MI:OFF_MF], p[..., OFF_MF:OFF_ZA],
            p[..., OFF_ZA:OFF_ZB], p[..., OFF_ZB:IN_COLS])


def mla_latent(ckv_raw, kpe_raw, pos, kv_a_norm, k_rope_norm):
    ckv = rmsnorm(ckv_raw, kv_a_norm)
    kpe = rope(rmsnorm(kpe_raw, k_rope_norm)[:, :, None, :], pos)[:, :, 0, :]
    return ckv, kpe


def mla_queries(cq_raw, pos, q_a_norm, w_q_up, q_nope_norm, q_rope_norm):
    B, T, _ = cq_raw.shape
    q = (rmsnorm(cq_raw, q_a_norm) @ w_q_up).reshape(B, T, MLA_HEADS, QK_NOPE + QK_ROPE)
    q_nope = rmsnorm(q[..., :QK_NOPE], q_nope_norm)
    q_pe = rope(rmsnorm(q[..., QK_NOPE:], q_rope_norm), pos)
    return q_nope, q_pe


def mla_expand(ckv, w_kv_up, k_nope_norm):
    B, S, _ = ckv.shape
    kv = (ckv @ w_kv_up).reshape(B, S, MLA_HEADS, QK_NOPE + V_HEAD)
    return rmsnorm(kv[..., :QK_NOPE], k_nope_norm), kv[..., QK_NOPE:]


def mla_attend(q_nope, q_pe, k_nope, k_pe, v, mask):
    s = (jnp.einsum('bqhd,bshd->bhqs', q_nope, k_nope)
         + jnp.einsum('bqhd,bsd->bhqs', q_pe, k_pe)).astype(jnp.float32) * ATTN_SCALE
    if mask is not None:
        s = jnp.where(mask[None, None], s, -jnp.inf)
    p = jax.nn.softmax(s, axis=-1).astype(v.dtype)
    return jnp.einsum('bhqs,bshd->bqhd', p, v)


def mla_prompt_attention(q_nope, q_pe, k_nope, k_pe, v):
    B, T = q_nope.shape[:2]
    n_qb = -(-T // Q_BLOCK)
    pad = n_qb * Q_BLOCK - T
    qn = jnp.pad(q_nope, ((0, 0), (0, pad), (0, 0), (0, 0)))
    qp = jnp.pad(q_pe, ((0, 0), (0, pad), (0, 0), (0, 0)))
    cid_k = chunk_id(jnp.arange(T))

    def one_block(i):
        start = i * Q_BLOCK
        cid_q = chunk_id(start + jnp.arange(Q_BLOCK))
        mask = cid_q[:, None] >= cid_k[None, :]
        return mla_attend(lax.dynamic_slice_in_dim(qn, start, Q_BLOCK, 1),
                          lax.dynamic_slice_in_dim(qp, start, Q_BLOCK, 1), k_nope, k_pe, v, mask)

    out = lax.map(one_block, jnp.arange(n_qb))
    return jnp.moveaxis(out, 0, 1).reshape(B, n_qb * Q_BLOCK, MLA_HEADS, V_HEAD)[:, :T]


def mlstm_block(carry, blk):
    C0, n0, m0 = carry
    q, k, v, ig, lf = blk
    L = q.shape[2]
    b = jnp.cumsum(lf, axis=-1)
    a = b + m0[..., None]
    D = b[..., :, None] - b[..., None, :] + ig[..., None, :]
    D = jnp.where(jnp.tril(jnp.ones((L, L), dtype=bool)), D, -jnp.inf)
    m = jnp.maximum(a, D.max(axis=-1))
    w_inter = jnp.exp(a - m)
    qk = jnp.einsum('bhtd,bhsd->bhts', q, k) * jnp.exp(D - m[..., None])
    num = w_inter[..., None] * jnp.einsum('bhtd,bhde->bhte', q, C0) + jnp.einsum('bhts,bhse->bhte', qk, v)
    den = w_inter * jnp.einsum('bhtd,bhd->bht', q, n0) + qk.sum(axis=-1)
    h = num / jnp.maximum(jnp.abs(den), jnp.exp(-m))[..., None]
    bL = b[..., -1]
    g = bL[..., None] - b + ig
    mL = jnp.maximum(bL + m0, g.max(axis=-1))
    decay = jnp.exp(bL + m0 - mL)
    ws = jnp.exp(g - mL[..., None])
    C1 = decay[..., None, None] * C0 + jnp.einsum('bhs,bhsd,bhse->bhde', ws, k, v)
    n1 = decay[..., None] * n0 + jnp.einsum('bhs,bhsd->bhd', ws, k)
    return (C1, n1, mL), h


def mlstm_branch(mq, mk, mv, mo, mi, mf, b_igate, b_fgate, ml_out_norm, state, block):
    B, T, _ = mq.shape
    f32 = jnp.float32
    heads = lambda a, d: a.reshape(B, T, ML_HEADS, d).transpose(0, 2, 1, 3).astype(f32)
    q = heads(mq, ML_DQK)
    k = heads(mk, ML_DQK) * (ML_DQK ** -0.5)
    v = heads(mv, ML_DV)
    ig = (mi + b_igate).astype(f32).transpose(0, 2, 1)
    lf = jax.nn.log_sigmoid((mf + b_fgate).astype(f32)).transpose(0, 2, 1)
    nb = T // block
    to_blocks = lambda a: jnp.moveaxis(a.reshape(B, ML_HEADS, nb, block, *a.shape[3:]), 2, 0)
    state = tuple(s.astype(f32) for s in state)
    state, h = lax.scan(mlstm_block, state,
                        (to_blocks(q), to_blocks(k), to_blocks(v), to_blocks(ig), to_blocks(lf)))
    h = jnp.moveaxis(h, 0, 2).reshape(B, ML_HEADS, T, ML_DV).transpose(0, 2, 1, 3)
    h = jax.nn.sigmoid(mo.astype(f32)).reshape(B, T, ML_HEADS, ML_DV) * rmsnorm(h, ml_out_norm)
    return h.reshape(B, T, ML_WIDTH).astype(mq.dtype), state


def merge(x_res, attn, za, ml_h, zb, w_out):
    B, T, _ = x_res.shape
    a = attn.reshape(B, T, MLA_WIDTH) * jax.nn.silu(za)
    m = ml_h * jax.nn.silu(zb)
    return x_res + jnp.concatenate([a, m], axis=-1) @ w_out


def prompt_path(x, params):
    (meta_tokens, norm_gain, w_in, b_igate, b_fgate, q_a_norm, w_q_up, q_nope_norm, q_rope_norm,
     kv_a_norm, k_rope_norm, w_kv_up, k_nope_norm, ml_out_norm, w_out) = params
    B, S, _ = x.shape
    T = N_META + S
    seq = jnp.concatenate([jnp.broadcast_to(meta_tokens.astype(x.dtype)[None], (B, N_META, D_MODEL)), x], axis=1)
    pos = jnp.arange(T)
    cq, ckv_raw, kpe_raw, mq, mk, mv, mo, mi, mf, za, zb = project(rmsnorm(seq, norm_gain), w_in)
    ckv, kpe = mla_latent(ckv_raw, kpe_raw, pos, kv_a_norm, k_rope_norm)
    q_nope, q_pe = mla_queries(cq, pos, q_a_norm, w_q_up, q_nope_norm, q_rope_norm)
    k_nope, v = mla_expand(ckv, w_kv_up, k_nope_norm)
    attn = mla_prompt_attention(q_nope, q_pe, k_nope, kpe, v)
    state0 = (jnp.zeros((B, ML_HEADS, ML_DQK, ML_DV), jnp.float32),
              jnp.zeros((B, ML_HEADS, ML_DQK), jnp.float32),
              jnp.zeros((B, ML_HEADS), jnp.float32))
    ml_h, (C, n, m) = mlstm_branch(mq, mk, mv, mo, mi, mf, b_igate, b_fgate, ml_out_norm, state0, ML_BLOCK)
    y = merge(seq, attn, za, ml_h, zb, w_out)[:, N_META:]
    return y, ckv, kpe, C, n, m


def sample_path(x, cache_ckv, cache_kpe, state, params):
    (meta_tokens, norm_gain, w_in, b_igate, b_fgate, q_a_norm, w_q_up, q_nope_norm, q_rope_norm,
     kv_a_norm, k_rope_norm, w_kv_up, k_nope_norm, ml_out_norm, w_out) = params
    B, L, _ = x.shape
    P = cache_ckv.shape[1]
    mp = rmsnorm(meta_tokens.astype(x.dtype), norm_gain)[None] @ w_in[:, OFF_CKV:OFF_MQ]
    meta_ckv, meta_kpe = mla_latent(mp[..., :KV_LORA], mp[..., KV_LORA:], jnp.arange(N_META), kv_a_norm, k_rope_norm)
    pos = N_META + P + jnp.arange(L)
    cq, ckv_raw, kpe_raw, mq, mk, mv, mo, mi, mf, za, zb = project(rmsnorm(x, norm_gain), w_in)
    ckv_new, kpe_new = mla_latent(ckv_raw, kpe_raw, pos, kv_a_norm, k_rope_norm)
    q_nope, q_pe = mla_queries(cq, pos, q_a_norm, w_q_up, q_nope_norm, q_rope_norm)
    ckv_all = jnp.concatenate([jnp.broadcast_to(meta_ckv, (B, N_META, KV_LORA)),
                               cache_ckv.astype(ckv_new.dtype), ckv_new], axis=1)
    kpe_all = jnp.concatenate([jnp.broadcast_to(meta_kpe, (B, N_META, QK_ROPE)),
                               cache_kpe.astype(kpe_new.dtype), kpe_new], axis=1)
    k_nope, v = mla_expand(ckv_all, w_kv_up, k_nope_norm)
    attn = mla_attend(q_nope, q_pe, k_nope, kpe_all, v, None)
    ml_h, (C, n, m) = mlstm_branch(mq, mk, mv, mo, mi, mf, b_igate, b_fgate, ml_out_norm, state, L)
    y = merge(x, attn, za, ml_h, zb, w_out)
    return y, ckv_new, kpe_new, C, n, m


def setup_inputs(seed: int = 0) -> dict:
    key = jax.random.key(seed)
    ks = jax.random.split(key, 24)
    nrm = lambda k, shape, s=1.0: s * jax.random.normal(k, shape, jnp.float32)
    gain = lambda k, shape: 1.0 + 0.02 * jax.random.normal(k, shape, jnp.float32)
    return {
        'x_prompt': nrm(ks[0], (BATCH, SEQ, D_MODEL)),
        'x_sample': nrm(ks[1], (DEC_BATCH, DEC_SEQ, D_MODEL)),
        'cache_ckv': nrm(ks[2], (DEC_BATCH, PAST_LEN, KV_LORA)),
        'cache_kpe': nrm(ks[3], (DEC_BATCH, PAST_LEN, QK_ROPE)),
        'state_C': nrm(ks[4], (DEC_BATCH, ML_HEADS, ML_DQK, ML_DV), 0.1),
        'state_n': nrm(ks[5], (DEC_BATCH, ML_HEADS, ML_DQK), 0.5),
        'state_m': nrm(ks[6], (DEC_BATCH, ML_HEADS)),
        'meta_tokens': nrm(ks[7], (N_META, D_MODEL)),
        'norm_gain': gain(ks[8], (D_MODEL,)),
        'w_in': nrm(ks[9], (D_MODEL, IN_COLS), D_MODEL ** -0.5),
        'b_igate': nrm(ks[10], (ML_HEADS,), 0.1),
        'b_fgate': 3.0 + nrm(ks[11], (ML_HEADS,), 0.1),
        'q_a_norm': gain(ks[12], (Q_LORA,)),
        'w_q_up': nrm(ks[13], (Q_LORA, MLA_HEADS * (QK_NOPE + QK_ROPE)), Q_LORA ** -0.5),
        'q_nope_norm': gain(ks[14], (QK_NOPE,)),
        'q_rope_norm': gain(ks[15], (QK_ROPE,)),
        'kv_a_norm': gain(ks[16], (KV_LORA,)),
        'k_rope_norm': gain(ks[17], (QK_ROPE,)),
        'w_kv_up': nrm(ks[18], (KV_LORA, MLA_HEADS * (QK_NOPE + V_HEAD)), KV_LORA ** -0.5),
        'k_nope_norm': gain(ks[19], (QK_NOPE,)),
        'ml_out_norm': gain(ks[20], (ML_HEADS, ML_DV)),
        'w_out': nrm(ks[21], (D_MIX, D_MODEL), D_MIX ** -0.5),
    }


def reference(x_prompt, x_sample, cache_ckv, cache_kpe, state_C, state_n, state_m, meta_tokens, norm_gain,
              w_in, b_igate, b_fgate, q_a_norm, w_q_up, q_nope_norm, q_rope_norm, kv_a_norm, k_rope_norm,
              w_kv_up, k_nope_norm, ml_out_norm, w_out):
    params = (meta_tokens, norm_gain, w_in, b_igate, b_fgate, q_a_norm, w_q_up, q_nope_norm, q_rope_norm,
              kv_a_norm, k_rope_norm, w_kv_up, k_nope_norm, ml_out_norm, w_out)
    y_prompt, ckv_p, kpe_p, C_p, n_p, m_p = prompt_path(x_prompt, params)
    y_sample, ckv_s, kpe_s, C_s, n_s, m_s = sample_path(x_sample, cache_ckv, cache_kpe,
                                                        (state_C, state_n, state_m), params)
    return (y_prompt, y_sample, ckv_p, kpe_p, C_p, n_p, m_p, ckv_s, kpe_s, C_s, n_s, m_s)
```

```cpp
#include <hip/hip_runtime.h>
#include <hip/hip_cooperative_groups.h>
#include <cstdio>
#include <cstdint>
namespace cg = cooperative_groups;

constexpr int DM = 4096, NB = 4, SEQ = 2048, NMETA = 16, TP = NMETA + SEQ, NSB = 8, LS = 32, PAST = 1024;
constexpr int QLORA = 1536, KVLORA = 512, ROPE = 64, NOPE = 128, VH = 128, HA = 16;
constexpr int MLH = 4, DQK = 256, DV = 512;
constexpr int IN_COLS = 12360;
constexpr float EPS = 1e-6f;
constexpr int XR_SAMPLE = 8192, XR_META = 8448, XR_REAL = 8464, XR_PAD = 8704, XR_OUT = 8448;
constexpr int NP = 12288, NPT = 12544;
constexpr int PC_CQ = 0, PC_CKV = 1536, PC_MQ = 2048, PC_MK = 3072, PC_MV = 4096, PC_MO = 6144, PC_ZA = 8192, PC_ZB = 10240;
constexpr int GP = 256, GC_KPE = 0, GC_MI = 64, GC_MF = 68;
constexpr int KRP = 2112, KRS = 1152, KR_SAMPLE0 = NB * KRP, NKR = KR_SAMPLE0 + NSB * KRS;
constexpr int QP = 3072, KVP = 4096;
constexpr float ATTN_SCALE = 0.07216878364870322f;
constexpr long O_YP = 0, O_YS = 33554432, O_CKVP = 34603008, O_KPEP = 38830080, O_CP = 39358464, O_NP = 41455616, O_MP = 41459712,
               O_CKVS = 41459728, O_KPES = 41590800, O_CS = 41607184, O_NS = 45801488, O_MS = 45809680, O_END = 45809712;
constexpr size_t MiB = 1u << 20;
constexpr size_t WS_CTL = 0, WS_WIN = 2 * MiB, WS_XN = 100 * MiB, WS_P = 168 * MiB, WS_G32 = 377 * MiB, WS_WQ = 386 * MiB, WS_WKV = 395 * MiB,
                 WS_WOUT = 399 * MiB, WS_CQN = 431 * MiB, WS_CKVA = 456 * MiB, WS_KPEA = 474 * MiB, WS_Q = 477 * MiB, WS_KV = 527 * MiB,
                 WS_SP = 665 * MiB, WS_KP = 670 * MiB, WS_SCAL = 688 * MiB, WS_CST = 690 * MiB, WS_END = 716 * MiB;
constexpr size_t WS_NUM = WS_WIN;
constexpr size_t WS_MIX = WS_XN;
constexpr size_t SC_DEN = 0, SC_MTOK = 256 * 1024, SC_TAB = 1024 * 1024, SC_GAIN = 1024 * 1024 + 768 * 1024;

#define RPOS(l) ((((l) & 31) << 1) | ((l) >> 5))
typedef unsigned short bf16;
typedef float f32x4 __attribute__((ext_vector_type(4)));
typedef unsigned u32x4 __attribute__((ext_vector_type(4)));
typedef unsigned u32x2 __attribute__((ext_vector_type(2)));

__device__ __forceinline__ unsigned f2bf(float f) { unsigned u = __builtin_bit_cast(unsigned, f); return (u + 0x7fffu + ((u >> 16) & 1u)) >> 16; }
__device__ __forceinline__ unsigned pk2(float lo, float hi) { return f2bf(lo) | (f2bf(hi) << 16); }
__device__ __forceinline__ float bf2f(unsigned short b) { return __builtin_bit_cast(float, (unsigned)b << 16); }
__device__ __forceinline__ float bflo(unsigned w) { return __builtin_bit_cast(float, w << 16); }
__device__ __forceinline__ float bfhi(unsigned w) { return __builtin_bit_cast(float, w & 0xffff0000u); }
__device__ __forceinline__ float wave_sum(float v) {
#pragma unroll
    for (int o = 1; o < 64; o <<= 1) v += __shfl_xor(v, o);
    return v;
}
__device__ __forceinline__ float wave_max(float v) {
#pragma unroll
    for (int o = 1; o < 64; o <<= 1) v = fmaxf(v, __shfl_xor(v, o));
    return v;
}
__device__ __forceinline__ float sigmoidf_(float x) { return __builtin_amdgcn_rcpf(1.f + __expf(-x)); }
__device__ __forceinline__ float siluf_(float x) { return x * __builtin_amdgcn_rcpf(1.f + __expf(-x)); }
__device__ __forceinline__ float logsigmoidf_(float x) { return fminf(x, 0.f) - log1pf(__expf(-fabsf(x))); }

struct Args { const float* in[22]; float* out; unsigned char* ws; int ph_lo, ph_hi; };

struct Ctx {
    const float *x_prompt, *x_sample, *cache_ckv, *cache_kpe, *state_C, *state_n, *state_m, *meta, *norm_gain, *w_in, *b_ig, *b_fg, *q_a_norm, *w_q_up,
        *q_nope_norm, *q_rope_norm, *kv_a_norm, *k_rope_norm, *w_kv_up, *k_nope_norm, *ml_out_norm, *w_out;
    float* out; unsigned char* ws;
    bf16 *XN, *P, *CQN, *CKVA, *KPEA, *Q, *KV, *MIX;
    float *G32, *NUM, *DEN, *MTOK, *CST;
    int tid, lane, wave, gw, NGW, nblk, blk;
};

__device__ __forceinline__ const float* xrow_ptr(const Ctx& c, int r) {
    return r < XR_SAMPLE ? c.x_prompt + (size_t)r * DM : (r < XR_META ? c.x_sample + (size_t)(r - XR_SAMPLE) * DM : c.meta + (size_t)(r - XR_META) * DM);
}
__device__ __forceinline__ int xrow_pos(int r) { return r < XR_SAMPLE ? NMETA + (r & (SEQ - 1)) : (r < XR_META ? NMETA + PAST + ((r - XR_SAMPLE) & (LS - 1)) : r - XR_META); }

namespace pg8 {
#define PG8_LAS __attribute__((address_space(3)))
typedef unsigned short bf16_t;
typedef short bf16x8 __attribute__((ext_vector_type(8)));
typedef float f32x4 __attribute__((ext_vector_type(4)));
typedef unsigned u32x4 __attribute__((ext_vector_type(4)));
constexpr int BM = 256, BK = 64, HALF = 128, HTB = HALF * BK * 2  , STAGE_BYTES = 8 * HTB, NXCD = 8, WGM = 8;

__host__ __device__ __forceinline__ int lds_byte(int r, int c) { const int st = (r >> 4) * 2 + (c >> 5), rr = r & 15, cc = c & 31, ob = rr * 64 + cc * 2; return st * 1024 + (ob ^ (((ob >> 9) & 1) << 5)); }
__host__ __device__ __forceinline__ void stage_rc(int b, int& R, int& C) { const int st = b / 1024, sb = b % 1024, swz = sb ^ (((sb >> 9) & 1) << 5); R = (st >> 1) * 16 + swz / 64; C = (st & 1) * 32 + (swz % 64) / 2; }
__host__ __device__ __forceinline__ int perm32(int rho) { const int n = rho >> 4, i = rho & 15; return 8 * (i >> 2) + 4 * n + (i & 3); }

struct Unit { int pm, pn; };
struct Gemm { const bf16_t* A; const bf16_t* Bt; int M, N, K; };

struct StaticOrder {
    int nM, nN, nwg, G, c;
    __host__ __device__ void init(int M, int N, int G_, int c_) { nM = M / BM; nN = N / BM; nwg = nM * nN; G = G_; c = c_; }
    __host__ __device__ bool next(int i, Unit& u) const {
        const long L = (long)i * G + c; if (L >= nwg) return false;
        int wgid = (int)L; { const int q = nwg / NXCD, r = nwg % NXCD, xcd = wgid % NXCD, off = wgid / NXCD; wgid = (xcd < r ? xcd * (q + 1) : r * (q + 1) + (xcd - r) * q) + off; }
        const int nig = WGM * nN, gid = wgid / nig, fm = gid * WGM, gsz = (nM - fm) < WGM ? (nM - fm) : WGM;
        u.pm = fm + ((wgid % nig) % gsz); u.pn = (wgid % nig) / gsz; return true;
    }
    __device__ __forceinline__ unsigned peek(const Unit&) const { return 0u; }
    __device__ __forceinline__ void a_ready(const Unit&, unsigned) const {}
    __device__ __forceinline__ void done(const Unit&) const {}
};

__device__ __forceinline__ unsigned cvt_pk_bf16(float lo, float hi) { unsigned r; asm volatile("v_cvt_pk_bf16_f32 %0, %1, %2" : "=v"(r) : "v"(lo), "v"(hi)); return r; }
template <class Epi, class Sched, bool ALIGN_EPI = false, bool SP2 = false>
__device__ __forceinline__ void gemm_phase(PG8_LAS unsigned char* lds, const Gemm g, const Sched& S, const Epi& E) {
    const int tid = threadIdx.x, wid = __builtin_amdgcn_readfirstlane(tid >> 6), lane = tid & 63, wr = wid >> 2, wc = wid & 3, fr = lane & 15, fq = lane >> 4;
    const int K = g.K, nt = K / BK;
    unsigned voffA[2], voffB[2];
#pragma unroll
    for (int i = 0; i < 2; ++i) { int R, C; stage_rc(tid * 16 + i * 8192, R, C); const int Rb = Epi::PERM ? ((R & ~31) + perm32(R & 31)) : R;
        voffA[i] = (unsigned)(R * K + C) * 2u; voffB[i] = (unsigned)(Rb * K + C) * 2u; }
    const size_t kstep = (size_t)(BK * 2);
    const size_t hstep = (size_t)HALF * K * 2;
    const size_t tstep = 2 * hstep;
    const unsigned ldsw = (unsigned)wid * 1024u;
    const int aoff = lds_byte(wr * 64 + fr, fq * 8), boff = lds_byte(wc * 32 + fr, fq * 8);
#define PG8_SA(b, h) (((b) * 2 + (h)) * HTB)
#define PG8_SB(b, h) ((4 + (b) * 2 + (h)) * HTB)
#define PG8_STAGE(bufoff, gbase, voff) do { _Pragma("unroll") for (int _i = 0; _i < 2; ++_i) \
        __builtin_amdgcn_global_load_lds((const unsigned*)((const char*)(gbase) + (voff)[_i]), (PG8_LAS unsigned*)(lds + (bufoff) + ldsw + _i * 8192), 16, 0, 0); } while (0)
#define PG8_LDA(dst, b, h) do { _Pragma("unroll") for (int m = 0; m < 4; ++m) _Pragma("unroll") for (int k = 0; k < 2; ++k) dst[m][k] = *(const PG8_LAS bf16x8*)(lds + PG8_SA(b, h) + aoff + m * 2048 + k * 1024); } while (0)
#define PG8_LDB(dst, b, h) do { _Pragma("unroll") for (int n = 0; n < 2; ++n) _Pragma("unroll") for (int k = 0; k < 2; ++k) dst[n][k] = *(const PG8_LAS bf16x8*)(lds + PG8_SB(b, h) + boff + n * 2048 + k * 1024); } while (0)
#define PG8_MMA(ai, bj, At, Bt) do { __builtin_amdgcn_s_setprio(1); _Pragma("unroll") for (int m = 0; m < 4; ++m) _Pragma("unroll") for (int n = 0; n < 2; ++n) _Pragma("unroll") for (int k = 0; k < 2; ++k) \
        acc[ai][bj][m][n] = __builtin_amdgcn_mfma_f32_16x16x32_bf16(Bt[n][k], At[m][k], acc[ai][bj][m][n], 0, 0, 0); __builtin_amdgcn_s_setprio(0); } while (0)
#define PG8_WAIT_V(n) asm volatile("s_waitcnt vmcnt(" #n ")" ::: "memory")
#define PG8_WAIT_L(n) asm volatile("s_waitcnt lgkmcnt(" #n ")" ::: "memory")
#define PG8_BAR __builtin_amdgcn_s_barrier()
#define PG8_SCHED __builtin_amdgcn_sched_barrier(0)
    Unit cur, nxt; int ui = 0;
    if (!S.next(0, cur)) return;
    f32x4 acc[2][2][4][2];
#pragma unroll
    for (int a = 0; a < 2; ++a)
#pragma unroll
        for (int b = 0; b < 2; ++b)
#pragma unroll
            for (int m = 0; m < 4; ++m)
#pragma unroll
                for (int n = 0; n < 2; ++n) acc[a][b][m][n] = (f32x4){0.f, 0.f, 0.f, 0.f};
    bf16x8 At[4][2], B0[2][2], B1[2][2];
    const char* cA = (const char*)g.A + (size_t)cur.pm * tstep; const char* cB = (const char*)g.Bt + (size_t)cur.pn * tstep;
    S.a_ready(cur, 0u);
    if constexpr (SP2) {
        PG8_STAGE(PG8_SB(0, 0), cB, voffB); PG8_STAGE(PG8_SB(0, 1), cB + hstep, voffB); PG8_STAGE(PG8_SA(0, 0), cA, voffA); PG8_STAGE(PG8_SA(0, 1), cA + hstep, voffA);
        if (wr == 1) PG8_BAR;
        PG8_WAIT_V(2); PG8_BAR;
        PG8_STAGE(PG8_SB(1, 0), cB + kstep, voffB); PG8_STAGE(PG8_SA(1, 0), cA + kstep, voffA); PG8_STAGE(PG8_SB(1, 1), cB + hstep + kstep, voffB);
        PG8_WAIT_V(6); PG8_BAR;
    } else {
        PG8_STAGE(PG8_SB(0, 0), cB, voffB); PG8_STAGE(PG8_SA(0, 0), cA, voffA); PG8_STAGE(PG8_SB(0, 1), cB + hstep, voffB); PG8_STAGE(PG8_SA(0, 1), cA + hstep, voffA);
        if (wr == 1) PG8_BAR;
        PG8_WAIT_V(4); PG8_BAR;
        PG8_STAGE(PG8_SB(1, 0), cB + kstep, voffB); PG8_STAGE(PG8_SA(1, 0), cA + kstep, voffA); PG8_STAGE(PG8_SB(1, 1), cB + hstep + kstep, voffB);
        PG8_WAIT_V(6); PG8_BAR;
    }
    for (;;) {
        const bool has_next = S.next(ui + 1, nxt);
        const unsigned pk = has_next ? S.peek(nxt) : 0u;
        const char* nA = has_next ? (const char*)g.A + (size_t)nxt.pm * tstep : cA; const char* nB = has_next ? (const char*)g.Bt + (size_t)nxt.pn * tstep : cB;
        for (int t = 0; t < nt; t += 2) {
            const bool last = (t == nt - 2);
            const char* a1 = cA + (size_t)(t + 1) * kstep;
            const char* a2 = last ? nA : cA + (size_t)(t + 2) * kstep; const char* b2 = last ? nB : cB + (size_t)(t + 2) * kstep;
            const char* a3 = a2 + kstep; const char* b3 = b2 + kstep;
            if (last && has_next) S.a_ready(nxt, pk);
            if constexpr (SP2) {
            PG8_LDB(B0, 0, 0); PG8_LDB(B1, 0, 1); PG8_SCHED; PG8_LDA(At, 0, 0); PG8_STAGE(PG8_SA(1, 1), a1 + hstep, voffA);
            PG8_WAIT_V(8); PG8_WAIT_L(0); PG8_BAR; PG8_MMA(0, 0, At, B0); PG8_MMA(0, 1, At, B1); PG8_BAR; PG8_SCHED;
            PG8_LDA(At, 0, 1); PG8_STAGE(PG8_SB(0, 0), b2, voffB); PG8_STAGE(PG8_SB(0, 1), b2 + hstep, voffB); PG8_STAGE(PG8_SA(0, 0), a2, voffA);
            PG8_WAIT_V(8); PG8_WAIT_L(0); PG8_BAR; PG8_MMA(1, 0, At, B0); PG8_MMA(1, 1, At, B1); PG8_BAR; PG8_SCHED;
            PG8_LDB(B0, 1, 0); PG8_LDB(B1, 1, 1); PG8_SCHED; PG8_LDA(At, 1, 0); PG8_STAGE(PG8_SA(0, 1), a2 + hstep, voffA);
            PG8_WAIT_V(8); PG8_WAIT_L(0); PG8_BAR; PG8_MMA(0, 0, At, B0); PG8_MMA(0, 1, At, B1); PG8_BAR; PG8_SCHED;
            PG8_LDA(At, 1, 1); PG8_STAGE(PG8_SB(1, 0), b3, voffB); PG8_STAGE(PG8_SB(1, 1), b3 + hstep, voffB); PG8_STAGE(PG8_SA(1, 0), a3, voffA);
            PG8_WAIT_V(8); PG8_WAIT_L(0); PG8_BAR; PG8_MMA(1, 0, At, B0); PG8_MMA(1, 1, At, B1); PG8_BAR; PG8_SCHED;
            } else {
            PG8_LDB(B0, 0, 0); PG8_SCHED; PG8_LDA(At, 0, 0); PG8_STAGE(PG8_SA(1, 1), a1 + hstep, voffA);
            PG8_WAIT_L(8); PG8_BAR; PG8_WAIT_L(0); PG8_MMA(0, 0, At, B0); PG8_BAR; PG8_SCHED;
            PG8_LDB(B1, 0, 1); PG8_STAGE(PG8_SB(0, 0), b2, voffB);
            PG8_BAR; PG8_WAIT_L(0); PG8_MMA(0, 1, At, B1); PG8_BAR;
            PG8_LDA(At, 0, 1); PG8_STAGE(PG8_SA(0, 0), a2, voffA);
            PG8_BAR; PG8_WAIT_L(0); PG8_MMA(1, 0, At, B0); PG8_BAR; PG8_SCHED;
            PG8_STAGE(PG8_SB(0, 1), b2 + hstep, voffB);
            PG8_WAIT_V(6); PG8_BAR; PG8_MMA(1, 1, At, B1); PG8_BAR;
            PG8_LDB(B0, 1, 0); PG8_SCHED; PG8_LDA(At, 1, 0); PG8_STAGE(PG8_SA(0, 1), a2 + hstep, voffA);
            PG8_WAIT_L(8); PG8_BAR; PG8_WAIT_L(0); PG8_MMA(0, 0, At, B0); PG8_BAR; PG8_SCHED;
            PG8_LDB(B1, 1, 1); PG8_STAGE(PG8_SB(1, 0), b3, voffB);
            PG8_BAR; PG8_WAIT_L(0); PG8_MMA(0, 1, At, B1); PG8_BAR;
            PG8_LDA(At, 1, 1); PG8_STAGE(PG8_SA(1, 0), a3, voffA);
            PG8_BAR; PG8_WAIT_L(0); PG8_MMA(1, 0, At, B0); PG8_BAR; PG8_SCHED;
            PG8_STAGE(PG8_SB(1, 1), b3 + hstep, voffB);
            PG8_WAIT_V(6); PG8_BAR; PG8_MMA(1, 1, At, B1); PG8_BAR;
            }
        }
        if constexpr (ALIGN_EPI) { if (wr == 0) PG8_BAR; }
        if constexpr (!Epi::AFTER_DRAIN) { E(acc, cur, wr, wc, fr, fq); S.done(cur); }
        if (!has_next) break;
#pragma unroll
        for (int a = 0; a < 2; ++a)
#pragma unroll
            for (int b = 0; b < 2; ++b)
#pragma unroll
                for (int m = 0; m < 4; ++m)
#pragma unroll
                    for (int n = 0; n < 2; ++n) acc[a][b][m][n] = (f32x4){0.f, 0.f, 0.f, 0.f};
        cur = nxt; cA = nA; cB = nB; ++ui;
        if constexpr (ALIGN_EPI) { if (wr == 1) PG8_BAR; }
    }
    PG8_WAIT_V(0);
    if constexpr (!ALIGN_EPI) { if (wr == 0) PG8_BAR; }
    PG8_BAR;
    if constexpr (Epi::AFTER_DRAIN) { E.fused(acc, cur, wr, wc, fr, fq, lds, wid, lane); S.done(cur); }
#undef PG8_SA
#undef PG8_SB
#undef PG8_STAGE
#undef PG8_LDA
#undef PG8_LDB
#undef PG8_MMA
#undef PG8_WAIT_V
#undef PG8_WAIT_L
#undef PG8_BAR
#undef PG8_SCHED
}
}


#define LAS __attribute__((address_space(3)))
#define LDS_WAIT() asm volatile("s_waitcnt lgkmcnt(0)" ::: "memory")

#define XB_TMO      128
#define XB_XCNT(j)  (256  + 64 * (j))
#define XB_XSUB(j)  (1280 + 64 * (j))
#define XB_XGEN(j)  (2304 + 64 * (j))
#define XB_TOP      3328
#define XB_TOPGEN   3392
#define XCD_BAR_WORDS 3456
#define XB_SPIN_CAP (1u << 18)

__device__ __forceinline__ unsigned xb_ld(unsigned* p)              { return __hip_atomic_load(p, __ATOMIC_RELAXED, __HIP_MEMORY_SCOPE_AGENT); }
__device__ __forceinline__ unsigned xb_add(unsigned* p, unsigned v) { return __hip_atomic_fetch_add(p, v, __ATOMIC_RELAXED, __HIP_MEMORY_SCOPE_AGENT); }
__device__ __forceinline__ unsigned xb_xcc_id() { return (unsigned)__builtin_amdgcn_s_getreg((3 << 11) | 20) & 0xFu; }
#define XB_SPIN(cond, bar) do { unsigned _sp = 0; while (cond) { __builtin_amdgcn_s_sleep(1); \
    if ((++_sp & 255u) == 0u) { if (xb_ld(&(bar)[XB_TMO])) break; if (_sp > XB_SPIN_CAP) { atomicAdd(&(bar)[XB_TMO], 1u); break; } } } } while (0)

struct XcdBarrier {
    unsigned* bar; unsigned x;
    volatile LAS unsigned* st;
};

__device__ __forceinline__ XcdBarrier xcd_barrier_post(unsigned* bar, volatile LAS unsigned* st) {
    XcdBarrier b; b.bar = bar; b.x = xb_xcc_id(); b.st = st;
    if (threadIdx.x == 0) (void)xb_add(&bar[XB_XCNT(b.x)], 1u);
    return b;
}
__device__ __forceinline__ void xcd_barrier_complete(unsigned* bar, unsigned x, unsigned& nloc, unsigned& nx) {
    const unsigned G = gridDim.x * gridDim.y * gridDim.z;
    unsigned sum, cnt, mine, sp = 0u;
    for (;;) {
        sum = 0u; cnt = 0u; mine = 0u;
#pragma unroll
        for (unsigned j = 0; j < 16; ++j) { const unsigned c = xb_ld(&bar[XB_XCNT(j)]); sum += c; cnt += (c > 0u) ? 1u : 0u; mine = (j == x) ? c : mine; }
        if (sum == G) break;
        __builtin_amdgcn_s_sleep(1);
        if ((++sp & 255u) == 0u) { if (xb_ld(&bar[XB_TMO])) break; if (sp > XB_SPIN_CAP) { atomicAdd(&bar[XB_TMO], 1u); break; } }
    }
    nloc = mine > 0u ? mine : 1u; nx = cnt > 0u ? cnt : 1u;
}

__device__ __forceinline__ void xcd_barrier(const XcdBarrier& b) {
    asm volatile("s_waitcnt vmcnt(0)" ::: "memory");
    __syncthreads();
    if (threadIdx.x == 0) {
        unsigned* bar = b.bar;
        __builtin_amdgcn_s_waitcnt(0);
        unsigned nloc = b.st[0], nx = b.st[1];
        if (nloc == 0u) { xcd_barrier_complete(bar, b.x, nloc, nx); b.st[0] = nloc; b.st[1] = nx; }
        const unsigned old = xb_add(&bar[XB_XSUB(b.x)], 1u);
        const unsigned gen = old / nloc;
        if (old + 1u == (gen + 1u) * nloc) {
            __builtin_amdgcn_fence(__ATOMIC_RELEASE, "agent");
            asm volatile("s_waitcnt vmcnt(0)" ::: "memory");
            const unsigned og = xb_add(&bar[XB_TOP], 1u);
            const unsigned tg = og / nx;
            if (og + 1u == (tg + 1u) * nx) xb_add(&bar[XB_TOPGEN], 1u);
            else XB_SPIN(xb_ld(&bar[XB_TOPGEN]) == tg, bar);
            __builtin_amdgcn_fence(__ATOMIC_ACQUIRE, "agent");
            xb_add(&bar[XB_XGEN(b.x)], 1u);
            asm volatile("s_waitcnt vmcnt(0)" ::: "memory");
        } else {
            XB_SPIN(xb_ld(&bar[XB_XGEN(b.x)]) == gen, bar);
            __builtin_amdgcn_fence(__ATOMIC_ACQUIRE, "agent");
            asm volatile("s_waitcnt vmcnt(0)" ::: "memory");
        }
    }
    __syncthreads();
}


struct EpiBf16 {
    static constexpr bool PERM = true, AFTER_DRAIN = false;
    bf16* O; int ldc;
    __device__ __forceinline__ void operator()(const pg8::f32x4 (&acc)[2][2][4][2], const pg8::Unit& u, int wr, int wc, int fr, int fq) const {
        const int row0 = u.pm * 256 + wr * 64 + fr, col0 = u.pn * 256 + wc * 32 + 8 * fq;
#pragma unroll
        for (int ai = 0; ai < 2; ++ai)
#pragma unroll
            for (int m = 0; m < 4; ++m) { bf16* rowp = O + (size_t)(row0 + ai * 128 + m * 16) * ldc + col0;
#pragma unroll
                for (int bj = 0; bj < 2; ++bj) { const pg8::f32x4 v0 = acc[ai][bj][m][0], v1 = acc[ai][bj][m][1];
                    u32x4 w; w.x = pg8::cvt_pk_bf16(v0[0], v0[1]); w.y = pg8::cvt_pk_bf16(v0[2], v0[3]); w.z = pg8::cvt_pk_bf16(v1[0], v1[1]); w.w = pg8::cvt_pk_bf16(v1[2], v1[3]);
                    *(u32x4*)(rowp + bj * 128) = w; } }
    }
};

struct EpiKV {
    static constexpr bool PERM = true, AFTER_DRAIN = false;
    bf16* O; const float* gain; LAS float* X;
    __device__ __forceinline__ void operator()(const pg8::f32x4 (&acc)[2][2][4][2], const pg8::Unit& u, int wr, int wc, int fr, int fq) const {
        const int row0 = u.pm * 256 + wr * 64 + fr, col0 = u.pn * 256 + wc * 32 + 8 * fq;
        const bool nrm = u.pn < 8;
        if (nrm) {
#pragma unroll
            for (int ai = 0; ai < 2; ++ai)
#pragma unroll
                for (int m = 0; m < 4; ++m)
#pragma unroll
                    for (int bj = 0; bj < 2; ++bj) { const pg8::f32x4 v0 = acc[ai][bj][m][0], v1 = acc[ai][bj][m][1];
                        float s = (v0[0] * v0[0] + v0[1] * v0[1]) + (v0[2] * v0[2] + v0[3] * v0[3]) + (v1[0] * v1[0] + v1[1] * v1[1]) + (v1[2] * v1[2] + v1[3] * v1[3]);
                        s += __shfl_xor(s, 16); s += __shfl_xor(s, 32);
                        if (fq == 0) X[((ai * 128 + wr * 64 + m * 16 + fr) * 2 + bj) * 4 + wc] = s; }
            asm volatile("s_waitcnt lgkmcnt(0)" ::: "memory"); __builtin_amdgcn_s_barrier(); asm volatile("" ::: "memory");
        }
        pg8::f32x4 g0 = {1.f, 1.f, 1.f, 1.f}, g1 = {1.f, 1.f, 1.f, 1.f};
        if (nrm) { g0 = *(const pg8::f32x4*)(gain + wc * 32 + 8 * fq); g1 = *(const pg8::f32x4*)(gain + wc * 32 + 8 * fq + 4); }
#pragma unroll
        for (int ai = 0; ai < 2; ++ai)
#pragma unroll
            for (int m = 0; m < 4; ++m) { bf16* rowp = O + (size_t)(row0 + ai * 128 + m * 16) * KVP + col0;
#pragma unroll
                for (int bj = 0; bj < 2; ++bj) {
                    float r = 1.f;
                    if (nrm) { const pg8::f32x4 p = *(const LAS pg8::f32x4*)(X + ((ai * 128 + wr * 64 + m * 16 + fr) * 2 + bj) * 4); r = rsqrtf(((p[0] + p[1]) + (p[2] + p[3])) * (1.f / NOPE) + EPS); }
                    const pg8::f32x4 v0 = acc[ai][bj][m][0] * r * g0, v1 = acc[ai][bj][m][1] * r * g1;
                    u32x4 w; w.x = pg8::cvt_pk_bf16(v0[0], v0[1]); w.y = pg8::cvt_pk_bf16(v0[2], v0[3]); w.z = pg8::cvt_pk_bf16(v1[0], v1[1]); w.w = pg8::cvt_pk_bf16(v1[2], v1[3]);
                    *(u32x4*)(rowp + bj * 128) = w; } }
    }
};

struct EpiQ {
    static constexpr bool PERM = true, AFTER_DRAIN = false;
    unsigned char* ws; LAS float* X;
    __device__ __forceinline__ void operator()(const pg8::f32x4 (&acc)[2][2][4][2], const pg8::Unit& u, int wr, int wc, int fr_, int fq_) const {
        int fr = fr_, fq = fq_; asm volatile("" : "+v"(fr), "+v"(fq));
        const int row0 = u.pm * 256 + wr * 64 + fr, col0 = u.pn * 256 + wc * 32 + 8 * fq;
        bf16* O = (bf16*)(ws + WS_Q); const float* tab = (const float*)(ws + WS_SCAL + SC_TAB); const float* gn = (const float*)(ws + WS_SCAL + SC_GAIN); const float* gr = gn + 128;
        const bool rope = u.pn >= 8;
#pragma unroll
        for (int ai = 0; ai < 2; ++ai)
#pragma unroll
            for (int m = 0; m < 4; ++m)
#pragma unroll
                for (int bj = 0; bj < 2; ++bj) { const pg8::f32x4 v0 = acc[ai][bj][m][0], v1 = acc[ai][bj][m][1];
                    float s = (v0[0] * v0[0] + v0[1] * v0[1]) + (v0[2] * v0[2] + v0[3] * v0[3]) + (v1[0] * v1[0] + v1[1] * v1[1]) + (v1[2] * v1[2] + v1[3] * v1[3]);
                    s += __shfl_xor(s, 16); s += __shfl_xor(s, 32);
                    if (fq == 0) X[((ai * 128 + wr * 64 + m * 16 + fr) * 2 + bj) * 4 + wc] = s; }
        asm volatile("s_waitcnt lgkmcnt(0)" ::: "memory"); __builtin_amdgcn_s_barrier(); asm volatile("" ::: "memory");
        if (!rope) {
            const pg8::f32x4 g0 = *(const pg8::f32x4*)(gn + wc * 32 + 8 * fq), g1 = *(const pg8::f32x4*)(gn + wc * 32 + 8 * fq + 4);
#pragma unroll
            for (int ai = 0; ai < 2; ++ai)
#pragma unroll
                for (int m = 0; m < 4; ++m) { bf16* rowp = O + (size_t)(row0 + ai * 128 + m * 16) * QP + col0;
#pragma unroll
                    for (int bj = 0; bj < 2; ++bj) {
                        const pg8::f32x4 p = *(const LAS pg8::f32x4*)(X + ((ai * 128 + wr * 64 + m * 16 + fr) * 2 + bj) * 4); const float r = rsqrtf(((p[0] + p[1]) + (p[2] + p[3])) * (1.f / NOPE) + EPS);
                        const pg8::f32x4 v0 = acc[ai][bj][m][0] * r * g0, v1 = acc[ai][bj][m][1] * r * g1;
                        u32x4 w; w.x = pg8::cvt_pk_bf16(v0[0], v0[1]); w.y = pg8::cvt_pk_bf16(v0[2], v0[3]); w.z = pg8::cvt_pk_bf16(v1[0], v1[1]); w.w = pg8::cvt_pk_bf16(v1[2], v1[3]);
                        *(u32x4*)(rowp + bj * 128) = w; } }
        } else {
            const int i0 = 16 * (wc & 1) + 4 * fq;
            const pg8::f32x4 ga = *(const pg8::f32x4*)(gr + i0), gb = *(const pg8::f32x4*)(gr + 32 + i0);
#pragma unroll
            for (int ai = 0; ai < 2; ++ai)
#pragma unroll
                for (int m = 0; m < 4; ++m) { const int row = row0 + ai * 128 + m * 16; bf16* rowp = O + (size_t)row * QP + col0;
                    const int pos = row < XR_SAMPLE ? NMETA + (row & (SEQ - 1)) : NMETA + PAST + ((row - XR_SAMPLE) & (LS - 1));
                    const pg8::f32x4 t0 = *(const pg8::f32x4*)(tab + (size_t)pos * 64 + 2 * i0), t1 = *(const pg8::f32x4*)(tab + (size_t)pos * 64 + 2 * i0 + 4);
#pragma unroll
                    for (int bj = 0; bj < 2; ++bj) {
                        const pg8::f32x4 p = *(const LAS pg8::f32x4*)(X + ((ai * 128 + wr * 64 + m * 16 + fr) * 2 + bj) * 4);
                        const float r = rsqrtf(((wc & 2) ? p[2] + p[3] : p[0] + p[1]) * (1.f / ROPE) + EPS);
                        const pg8::f32x4 v0 = acc[ai][bj][m][0] * r, v1 = acc[ai][bj][m][1] * r;
                        const float a0 = v0[0] * ga[0], b0 = v0[1] * gb[0], a1 = v0[2] * ga[1], b1 = v0[3] * gb[1], a2 = v1[0] * ga[2], b2 = v1[1] * gb[2], a3 = v1[2] * ga[3], b3 = v1[3] * gb[3];
                        u32x4 w; w.x = pg8::cvt_pk_bf16(a0 * t0[0] - b0 * t0[1], b0 * t0[0] + a0 * t0[1]); w.y = pg8::cvt_pk_bf16(a1 * t0[2] - b1 * t0[3], b1 * t0[2] + a1 * t0[3]);
                        w.z = pg8::cvt_pk_bf16(a2 * t1[0] - b2 * t1[1], b2 * t1[0] + a2 * t1[1]); w.w = pg8::cvt_pk_bf16(a3 * t1[2] - b3 * t1[3], b3 * t1[2] + a3 * t1[3]);
                        *(u32x4*)(rowp + bj * 128) = w; }
                    __builtin_amdgcn_sched_barrier(0); }
        }
    }
};
struct EpiProj {
    static constexpr bool PERM = true, AFTER_DRAIN = false;
    bf16* P; float* G;
    __device__ __forceinline__ void operator()(const pg8::f32x4 (&acc)[2][2][4][2], const pg8::Unit& u, int wr, int wc, int fr, int fq) const {
        const int row0 = u.pm * 256 + wr * 64 + fr;
        if (u.pn < NP / 256) {
            const int col0 = u.pn * 256 + wc * 32 + 8 * fq;
#pragma unroll
            for (int ai = 0; ai < 2; ++ai)
#pragma unroll
                for (int m = 0; m < 4; ++m) { bf16* rowp = P + (size_t)(row0 + ai * 128 + m * 16) * NP + col0;
#pragma unroll
                    for (int bj = 0; bj < 2; ++bj) { const pg8::f32x4 v0 = acc[ai][bj][m][0], v1 = acc[ai][bj][m][1];
                        u32x4 w; w.x = pg8::cvt_pk_bf16(v0[0], v0[1]); w.y = pg8::cvt_pk_bf16(v0[2], v0[3]); w.z = pg8::cvt_pk_bf16(v1[0], v1[1]); w.w = pg8::cvt_pk_bf16(v1[2], v1[3]);
                        *(u32x4*)(rowp + bj * 128) = w; } }
        } else {
            const int col0 = wc * 32 + 8 * fq;
#pragma unroll
            for (int ai = 0; ai < 2; ++ai)
#pragma unroll
                for (int m = 0; m < 4; ++m) { float* rowp = G + (size_t)(row0 + ai * 128 + m * 16) * GP + col0;
#pragma unroll
                    for (int bj = 0; bj < 2; ++bj) { *(pg8::f32x4*)(rowp + bj * 128) = acc[ai][bj][m][0]; *(pg8::f32x4*)(rowp + bj * 128 + 4) = acc[ai][bj][m][1]; } }
        }
    }
};
struct EpiY {
    static constexpr bool PERM = false, AFTER_DRAIN = false;
    const float* xp; const float* xs; float* out;
    __device__ __forceinline__ void operator()(const pg8::f32x4 (&acc)[2][2][4][2], const pg8::Unit& u, int wr, int wc, int fr, int fq) const {
        const int row0 = u.pm * 256 + wr * 64 + fr, col0 = u.pn * 256 + wc * 32 + 4 * fq;
        const float* xb = u.pm < XR_SAMPLE / 256 ? xp : xs - (size_t)XR_SAMPLE * DM;
#pragma unroll
        for (int ai = 0; ai < 2; ++ai)
#pragma unroll
            for (int m = 0; m < 4; ++m) { const size_t off = (size_t)(row0 + ai * 128 + m * 16) * DM + col0;
#pragma unroll
                for (int bj = 0; bj < 2; ++bj)
#pragma unroll
                    for (int n = 0; n < 2; ++n) { const pg8::f32x4 xv = *(const pg8::f32x4*)(xb + off + bj * 128 + n * 16); *(pg8::f32x4*)(out + off + bj * 128 + n * 16) = xv + acc[ai][bj][m][n]; } }
    }
};


struct SplitOrder : pg8::StaticOrder {
    __device__ bool next(int i, pg8::Unit& u) const {
        long L;
        if (c < 140) { if (i >= 3) return false; L = (long)i * 140 + c; } else { L = 420 + (long)i * 116 + (c - 140); }
        if (L >= nwg) return false;
        int wgid = (int)L; { const int q = nwg / pg8::NXCD, r = nwg % pg8::NXCD, xcd = wgid % pg8::NXCD, off = wgid / pg8::NXCD; wgid = (xcd < r ? xcd * (q + 1) : r * (q + 1) + (xcd - r) * q) + off; }
        const int nig = pg8::WGM * nN, gid = wgid / nig, fm = gid * pg8::WGM, gsz = (nM - fm) < pg8::WGM ? (nM - fm) : pg8::WGM;
        u.pm = fm + ((wgid % nig) % gsz); u.pn = (wgid % nig) / gsz; return true;
    }
};


constexpr int RO_GEMM = 238, RO_NEED = (256 - RO_GEMM) * 8, RO_TPR = 7, RO_PRE = 2, CW_ROUND = 320;
struct RoundOrder {
    int wg; unsigned* flags; LAS unsigned* slot;
    __device__ __forceinline__ void init(int blk, unsigned* fl, LAS unsigned* sl) { slot = sl; const int x = blk & 7, j = blk >> 3; wg = blk < RO_GEMM ? (x < 6 ? x * 30 : 180 + (x - 6) * 29) + j : -1; flags = fl; }
    __device__ __forceinline__ bool next(int i, pg8::Unit& u) const { if (wg < 0 || i >= 7) return false; u.pm = wg / RO_TPR; u.pn = RO_TPR * i + wg % RO_TPR; return true; }
    __device__ __forceinline__ unsigned peek(const pg8::Unit& u) const {
        const int r = u.pn / RO_TPR; if (r < RO_PRE) return 0u;
        __builtin_amdgcn_global_load_lds(flags + 32 * r, slot, 4, 0, 17);
        return 0u;
    }
    __device__ __forceinline__ void a_ready(const pg8::Unit& u, unsigned pk) const {
        const int r = u.pn / RO_TPR; if (r < RO_PRE) return;
        unsigned v; asm volatile("ds_read_b32 %0, %1\n\ts_waitcnt lgkmcnt(0)" : "=v"(v) : "v"((unsigned)(uintptr_t)slot + 4u * (threadIdx.x & 63u)) : "memory");
        if (v >= (unsigned)RO_NEED) return;
        unsigned* f = flags + 32 * r;
        while (__hip_atomic_load(f, __ATOMIC_RELAXED, __HIP_MEMORY_SCOPE_AGENT) < (unsigned)RO_NEED) __builtin_amdgcn_s_sleep(16);
        asm volatile("" ::: "memory");
    }
    __device__ __forceinline__ void done(const pg8::Unit&) const {}
};

__device__ __forceinline__ void skinny_out(const Ctx& c, LAS unsigned char* lds, const bf16* Wt) {
    using bf16x8 = __attribute__((ext_vector_type(8))) short; using f32x16 = __attribute__((ext_vector_type(16))) float;
    const int mt = c.blk >> 6, nt = c.blk & 63, lane = c.lane, w = c.wave, r32 = lane & 31, hi = lane >> 5;
    const bf16* Ab = c.MIX + (size_t)(XR_SAMPLE + 64 * mt + r32) * DM + 512 * w + 32 * hi; const bf16* Bb = Wt + (size_t)(64 * nt + r32) * DM + 512 * w + 32 * hi;
    f32x16 acc[2][2] = {};
#pragma unroll 2
    for (int g = 0; g < 8; ++g) {
        bf16x8 a0[4], a1[4], b0[4], b1[4];
#pragma unroll
        for (int s = 0; s < 4; ++s) { a0[s] = *(const bf16x8*)(Ab + g * 64 + s * 8); a1[s] = *(const bf16x8*)(Ab + (size_t)32 * DM + g * 64 + s * 8);
            b0[s] = *(const bf16x8*)(Bb + g * 64 + s * 8); b1[s] = *(const bf16x8*)(Bb + (size_t)32 * DM + g * 64 + s * 8); }
#pragma unroll
        for (int s = 0; s < 4; ++s) {
            acc[0][0] = __builtin_amdgcn_mfma_f32_32x32x16_bf16(a0[s], b0[s], acc[0][0], 0, 0, 0); acc[0][1] = __builtin_amdgcn_mfma_f32_32x32x16_bf16(a0[s], b1[s], acc[0][1], 0, 0, 0);
            acc[1][0] = __builtin_amdgcn_mfma_f32_32x32x16_bf16(a1[s], b0[s], acc[1][0], 0, 0, 0); acc[1][1] = __builtin_amdgcn_mfma_f32_32x32x16_bf16(a1[s], b1[s], acc[1][1], 0, 0, 0); }
    }
    LAS float* part = (LAS float*)lds + w * 4096;
#pragma unroll
    for (int tb = 0; tb < 2; ++tb)
#pragma unroll
        for (int nb = 0; nb < 2; ++nb)
#pragma unroll
            for (int r = 0; r < 16; ++r) part[(32 * tb + (r & 3) + 8 * (r >> 2) + 4 * hi) * 64 + 32 * nb + r32] = acc[tb][nb][r];
    __syncthreads();
    { const int row = c.tid >> 3, c8 = (c.tid & 7) * 8; f32x4 s0 = {0.f, 0.f, 0.f, 0.f}, s1 = {0.f, 0.f, 0.f, 0.f};
#pragma unroll
        for (int p = 0; p < 8; ++p) { const LAS f32x4* q = (const LAS f32x4*)((LAS float*)lds + p * 4096 + row * 64 + c8); s0 += q[0]; s1 += q[1]; }
        const size_t off = (size_t)(64 * mt + row) * DM + 64 * nt + c8;
        const f32x4 x0 = *(const f32x4*)(c.x_sample + off), x1 = *(const f32x4*)(c.x_sample + off + 4);
        *(f32x4*)(c.out + O_YS + off) = x0 + s0; *(f32x4*)(c.out + O_YS + off + 4) = x1 + s1; }
    __syncthreads();
}

template <bool GATHER = false, class CMap>
__device__ __forceinline__ void transpose_item(const float* W, int ldw, int K, bf16* WT, LAS unsigned* scr, int item, int nblk, int lane, CMap cmap) {
    const int kb = item / nblk, nb = item % nblk, k0 = 64 * kb, n0 = 64 * nb;
    const int cg = lane & 15, kp = lane >> 4;
    const int src = cmap(n0 + 4 * cg);
    const float* wp = W + (size_t)k0 * ldw + (src >= 0 ? src : 0);
    f32x4 v[16];
    if (GATHER && cmap(n0 + 4 * cg + 1) != src + 1) {
        const float* w0 = W + (size_t)k0 * ldw; const int s1 = cmap(n0 + 4 * cg + 1), s2 = cmap(n0 + 4 * cg + 2), s3 = cmap(n0 + 4 * cg + 3);
#pragma unroll
        for (int i = 0; i < 16; ++i) { const int kk = 8 * (i >> 1) + 2 * kp + (i & 1); const float* r = w0 + (size_t)kk * ldw; v[i] = (f32x4){r[src], r[s1], r[s2], r[s3]}; }
    } else {
#pragma unroll
    for (int i = 0; i < 8; ++i) { const int kk = 8 * i + 2 * kp;
        v[2 * i] = src >= 0 ? __builtin_nontemporal_load((const f32x4*)(wp + (size_t)kk * ldw)) : (f32x4){0.f, 0.f, 0.f, 0.f};
        v[2 * i + 1] = src >= 0 ? __builtin_nontemporal_load((const f32x4*)(wp + (size_t)(kk + 1) * ldw)) : (f32x4){0.f, 0.f, 0.f, 0.f}; }
    }
#pragma unroll
    for (int i = 0; i < 8; ++i) { const int kpi = 4 * i + kp;
#pragma unroll
        for (int e = 0; e < 4; ++e) scr[(4 * cg + e) * 33 + kpi] = pk2(v[2 * i][e], v[2 * i + 1][e]); }
    LDS_WAIT(); asm volatile("" ::: "memory");
#pragma unroll
    for (int j = 0; j < 8; ++j) { const int id = j * 64 + lane, row = id >> 3, ch = id & 7; const LAS unsigned* s = scr + row * 33 + ch * 4;
        u32x4 o; o.x = s[0]; o.y = s[1]; o.z = s[2]; o.w = s[3];
        *(u32x4*)(WT + (size_t)(n0 + row) * K + k0 + 8 * ch) = o; }
    LDS_WAIT(); asm volatile("" ::: "memory");
}
__device__ __forceinline__ int cmap_win(int n) { return n < 2048 ? n : (n < 8192 ? n + 64 : (n < 12288 ? n + 72 : (n < 12352 ? n - 12288 + 2048 : (n < 12360 ? n - 12352 + 8256 : -1)))); }
__device__ __forceinline__ int cmap_wq(int n) { return n < 2048 ? (n >> 7) * 192 + (n & 127) : ((n - 2048) >> 6) * 192 + 128 + ((n & 1) << 5) + ((n & 63) >> 1); }
__device__ __forceinline__ int cmap_wkv(int n) { return n < 2048 ? (n >> 7) * 256 + (n & 127) : ((n - 2048) >> 7) * 256 + 128 + (n & 127); }
__device__ __forceinline__ int cmap_id(int n) { return n; }
template <int WHICH>
__device__ __forceinline__ void convert_weight(const float* W, bf16* WT, LAS unsigned* scr, int gw, int NGW, int lane) {
    constexpr int K = WHICH == 0 ? DM : (WHICH == 1 ? QLORA : (WHICH == 2 ? KVLORA : DM));
    constexpr int NN = WHICH == 0 ? NPT : (WHICH == 1 ? QP : (WHICH == 2 ? KVP : DM));
    constexpr int LDW = WHICH == 0 ? IN_COLS : (WHICH == 1 ? 3072 : (WHICH == 2 ? 4096 : DM));
    constexpr int nblk = NN / 64, nitems = (K / 64) * nblk;
    for (int it = gw; it < nitems; it += NGW) {
        if (WHICH == 0) transpose_item(W, LDW, K, WT, scr, it, nblk, lane, cmap_win);
        else if (WHICH == 1) transpose_item<true>(W, LDW, K, WT, scr, it, nblk, lane, cmap_wq);
        else if (WHICH == 2) transpose_item(W, LDW, K, WT, scr, it, nblk, lane, cmap_wkv);
        else transpose_item(W, LDW, K, WT, scr, it, nblk, lane, cmap_id);
    }
}

__device__ __forceinline__ void convert_win_round(const float* W, bf16* WT, LAS unsigned* scr, int r, int w, int nw, int lane) {
    constexpr int NB = RO_TPR * 4, NBA = NPT / 64;
    for (int it = w; it < (DM / 64) * NB; it += nw) { const int kb = it / NB, nbl = it % NB; transpose_item(W, IN_COLS, DM, WT, scr, kb * NBA + NB * r + nbl, NBA, lane, cmap_win); }
}

__device__ __forceinline__ void phase0(const Ctx& c) {
#define P0_LOAD(V, r_) do { if ((r_) < XR_REAL) { const f32x4* xr_ = (const f32x4*)xrow_ptr(c, (r_)) + 2 * c.lane; _Pragma("unroll") for (int j = 0; j < 8; ++j) { V[2 * j] = __builtin_nontemporal_load(xr_ + 128 * j); V[2 * j + 1] = __builtin_nontemporal_load(xr_ + 128 * j + 1); } } } while (0)
#define P0_ROW(V, r_) do { if ((r_) < XR_PAD) { u32x4* o = (u32x4*)(c.XN + (size_t)(r_) * DM) + c.lane; \
        if ((r_) >= XR_REAL) { _Pragma("unroll") for (int j = 0; j < 8; ++j) o[64 * j] = (u32x4){0u, 0u, 0u, 0u}; } \
        else { float s = 0.f; _Pragma("unroll") for (int j = 0; j < 16; ++j) s += (V[j].x * V[j].x + V[j].y * V[j].y) + (V[j].z * V[j].z + V[j].w * V[j].w); \
            const float rs = rsqrtf(wave_sum(s) * (1.f / DM) + EPS); const f32x4* g = (const f32x4*)c.norm_gain + 2 * c.lane; \
            _Pragma("unroll") for (int j = 0; j < 8; ++j) { const f32x4 g0 = g[128 * j], g1 = g[128 * j + 1]; \
                o[64 * j] = (u32x4){pk2(V[2 * j].x * rs * g0.x, V[2 * j].y * rs * g0.y), pk2(V[2 * j].z * rs * g0.z, V[2 * j].w * rs * g0.w), pk2(V[2 * j + 1].x * rs * g1.x, V[2 * j + 1].y * rs * g1.y), pk2(V[2 * j + 1].z * rs * g1.z, V[2 * j + 1].w * rs * g1.w)}; } } } } while (0)
    {   f32x4 va[16], vb[16];
        int r = c.gw; P0_LOAD(va, r);
        for (; r < XR_PAD; r += 2 * c.NGW) {
            P0_LOAD(vb, r + c.NGW); P0_ROW(va, r);
            P0_LOAD(va, r + 2 * c.NGW); P0_ROW(vb, r + c.NGW);
        } }
#undef P0_LOAD
#undef P0_ROW
    { float* tab = (float*)(c.ws + WS_SCAL + SC_TAB);
      for (int e = c.gw * 64 + c.lane; e < 2112 * 32; e += c.NGW * 64) { const int pos = e >> 5, i = e & 31; const float invf = exp2f(-(float)i * (13.287712379549449f / 32.f)); float sn, cs; sincosf((float)pos * invf, &sn, &cs); tab[2 * e] = cs; tab[2 * e + 1] = sn; } }
    if (c.blk == 0 && c.tid < 192) { float* gsc = (float*)(c.ws + WS_SCAL + SC_GAIN); gsc[c.tid] = c.tid < 128 ? c.q_nope_norm[c.tid] : c.q_rope_norm[c.tid - 128]; }
    for (int kr = c.gw; kr < NKR; kr += c.NGW) {
        int kind = 0; const float* src = nullptr; const float* srck = nullptr;
        if (kr < KR_SAMPLE0) { const int i = kr % KRP; if (i >= NMETA && i < 64) kind = 1; }
        else { const int b = (kr - KR_SAMPLE0) / KRS, i = (kr - KR_SAMPLE0) % KRS;
            if ((i >= NMETA && i < 64) || i >= 64 + PAST + LS) kind = 1;
            else if (i >= 64 && i < 64 + PAST) { kind = 2; src = c.cache_ckv + ((size_t)b * PAST + (i - 64)) * KVLORA; srck = c.cache_kpe + ((size_t)b * PAST + (i - 64)) * ROPE; } }
        if (kind == 0) continue;
        u32x4* o = (u32x4*)(c.CKVA + (size_t)kr * KVLORA) + c.lane;
        if (kind == 1) { *o = (u32x4){0u, 0u, 0u, 0u}; c.KPEA[(size_t)kr * ROPE + RPOS(c.lane)] = 0; }
        else { const f32x4 a = ((const f32x4*)src)[2 * c.lane], b2 = ((const f32x4*)src)[2 * c.lane + 1];
            *o = (u32x4){pk2(a.x, a.y), pk2(a.z, a.w), pk2(b2.x, b2.y), pk2(b2.z, b2.w)}; c.KPEA[(size_t)kr * ROPE + RPOS(c.lane)] = (bf16)f2bf(srck[c.lane]); }
    }
}

__device__ __forceinline__ void p2_row(const Ctx& c, int r, const u32x4 (&v)[3], const u32x4 kvv, float kp, float cs, float sn) {
        if (r < XR_OUT) {
            float s = 0.f;
#pragma unroll
            for (int j = 0; j < 3; ++j) {
#pragma unroll
                for (int e = 0; e < 4; ++e) { const float a = bflo(v[j][e]), b = bfhi(v[j][e]); s += a * a + b * b; } }
            const float rs = rsqrtf(wave_sum(s) * (1.f / QLORA) + EPS);
#pragma unroll
            for (int j = 0; j < 3; ++j) { const f32x4 g0 = ((const f32x4*)c.q_a_norm)[2 * (64 * j + c.lane)], g1 = ((const f32x4*)c.q_a_norm)[2 * (64 * j + c.lane) + 1];
                u32x4 o; o.x = pk2(bflo(v[j].x) * rs * g0.x, bfhi(v[j].x) * rs * g0.y); o.y = pk2(bflo(v[j].y) * rs * g0.z, bfhi(v[j].y) * rs * g0.w);
                o.z = pk2(bflo(v[j].z) * rs * g1.x, bfhi(v[j].z) * rs * g1.y); o.w = pk2(bflo(v[j].w) * rs * g1.z, bfhi(v[j].w) * rs * g1.w);
                ((u32x4*)(c.CQN + (size_t)r * QLORA))[64 * j + c.lane] = o; }
        }
        float cv[8]; float s = 0.f;
        {
#pragma unroll
            for (int e = 0; e < 4; ++e) { cv[2 * e] = bflo(kvv[e]); cv[2 * e + 1] = bfhi(kvv[e]); s += cv[2 * e] * cv[2 * e] + cv[2 * e + 1] * cv[2 * e + 1]; } }
        const float rs = rsqrtf(wave_sum(s) * (1.f / KVLORA) + EPS);
        { const f32x4 g0 = ((const f32x4*)c.kv_a_norm)[2 * c.lane], g1 = ((const f32x4*)c.kv_a_norm)[2 * c.lane + 1];
            cv[0] *= rs * g0.x; cv[1] *= rs * g0.y; cv[2] *= rs * g0.z; cv[3] *= rs * g0.w; cv[4] *= rs * g1.x; cv[5] *= rs * g1.y; cv[6] *= rs * g1.z; cv[7] *= rs * g1.w; }
        const float rk = rsqrtf(wave_sum(kp * kp) * (1.f / ROPE) + EPS);
        kp *= rk * c.k_rope_norm[c.lane];
        { const float other = __shfl_xor(kp, 32); kp = c.lane < 32 ? kp * cs - other * sn : kp * cs + other * sn; }
        const u32x4 cb = (u32x4){pk2(cv[0], cv[1]), pk2(cv[2], cv[3]), pk2(cv[4], cv[5]), pk2(cv[6], cv[7])};
        const f32x4 c0 = (f32x4){cv[0], cv[1], cv[2], cv[3]}, c1 = (f32x4){cv[4], cv[5], cv[6], cv[7]};
        const bf16 kb = (bf16)f2bf(kp);
        if (r < XR_SAMPLE) {
            const int b = r >> 11, j = r & (SEQ - 1);
            float* oc = c.out + O_CKVP + ((size_t)b * TP + NMETA + j) * KVLORA; ((f32x4*)oc)[2 * c.lane] = c0; ((f32x4*)oc)[2 * c.lane + 1] = c1;
            c.out[O_KPEP + ((size_t)b * TP + NMETA + j) * ROPE + c.lane] = kp;
            const size_t kr = (size_t)b * KRP + 64 + j; ((u32x4*)(c.CKVA + kr * KVLORA))[c.lane] = cb; c.KPEA[kr * ROPE + RPOS(c.lane)] = kb;
        } else if (r < XR_META) {
            const int b = (r - XR_SAMPLE) >> 5, l = (r - XR_SAMPLE) & (LS - 1);
            float* oc = c.out + O_CKVS + ((size_t)b * LS + l) * KVLORA; ((f32x4*)oc)[2 * c.lane] = c0; ((f32x4*)oc)[2 * c.lane + 1] = c1;
            c.out[O_KPES + ((size_t)b * LS + l) * ROPE + c.lane] = kp;
            const size_t kr = (size_t)KR_SAMPLE0 + (size_t)b * KRS + 64 + PAST + l; ((u32x4*)(c.CKVA + kr * KVLORA))[c.lane] = cb; c.KPEA[kr * ROPE + RPOS(c.lane)] = kb;
        } else {
            const int m = r - XR_META;
            for (int b = 0; b < NB; ++b) { float* oc = c.out + O_CKVP + ((size_t)b * TP + m) * KVLORA; ((f32x4*)oc)[2 * c.lane] = c0; ((f32x4*)oc)[2 * c.lane + 1] = c1;
                c.out[O_KPEP + ((size_t)b * TP + m) * ROPE + c.lane] = kp;
                const size_t kr = (size_t)b * KRP + m; ((u32x4*)(c.CKVA + kr * KVLORA))[c.lane] = cb; c.KPEA[kr * ROPE + RPOS(c.lane)] = kb; }
            for (int b = 0; b < NSB; ++b) { const size_t kr = (size_t)KR_SAMPLE0 + (size_t)b * KRS + m; ((u32x4*)(c.CKVA + kr * KVLORA))[c.lane] = cb; c.KPEA[kr * ROPE + RPOS(c.lane)] = kb; }
        }
}
__device__ __forceinline__ void phase2_rows(const Ctx& c) {
    u32x4 qa[3], qb[3], kva, kvb; float kpa = 0.f, kpb = 0.f, csa = 0.f, sna = 0.f, csb = 0.f, snb = 0.f;
#define P2_LOAD(Q, KV, KP, CS, SN, r_) do { if ((r_) < XR_REAL) { const bf16* prow_ = c.P + (size_t)(r_) * NP; \
        if ((r_) < XR_OUT) { _Pragma("unroll") for (int j = 0; j < 3; ++j) Q[j] = ((const u32x4*)(prow_ + PC_CQ))[64 * j + c.lane]; } \
        KV = ((const u32x4*)(prow_ + PC_CKV))[c.lane]; KP = c.G32[(size_t)(r_) * GP + GC_KPE + c.lane]; \
        const float* tb_ = (const float*)(c.ws + WS_SCAL + SC_TAB) + (size_t)xrow_pos(r_) * 64 + 2 * (c.lane & 31); CS = tb_[0]; SN = tb_[1]; } } while (0)
#define P2_ROW(Q, KV, KP, CS, SN, r_) do { if ((r_) < XR_REAL) p2_row(c, (r_), Q, KV, KP, CS, SN); } while (0)
    int r = c.gw; P2_LOAD(qa, kva, kpa, csa, sna, r);
    for (; r < XR_REAL; r += 2 * c.NGW) {
        P2_LOAD(qb, kvb, kpb, csb, snb, r + c.NGW); P2_ROW(qa, kva, kpa, csa, sna, r);
        P2_LOAD(qa, kva, kpa, csa, sna, r + 2 * c.NGW); P2_ROW(qb, kvb, kpb, csb, snb, r + c.NGW);
    }
#undef P2_LOAD
#undef P2_ROW
}

namespace att {
using bf16x8 = __attribute__((ext_vector_type(8))) short;
using s16x4 = __attribute__((ext_vector_type(4))) short;
using f32x16 = __attribute__((ext_vector_type(16))) float;
constexpr int SHM_KN = 64 * 128 * 2, SHM_KR = 64 * 64 * 2, SHM_V = 64 * 128 * 2, SHM_BUF = SHM_KN + SHM_KR + SHM_V;
constexpr int OFF_WS = 2 * SHM_BUF;
constexpr float CEXP = ATTN_SCALE * 1.4426950408889634f;
constexpr float THR = 8.f;
#define ATT_KSWZ(row, colB) ((row) * 256 + ((colB) ^ (((row) & 15) << 4)))
#define ATT_RSWZ(row, ch) ((row) * 128 + ((((ch) ^ ((row) >> 1)) & 7) << 4))
#define ATT_SBAR() __builtin_amdgcn_sched_barrier(0)
__device__ __forceinline__ int crow(int r, int hi) { return (r & 3) + 8 * (r >> 2) + 4 * hi; }
__device__ __forceinline__ unsigned cvtpk(float lo, float hi) { unsigned r; asm volatile("v_cvt_pk_bf16_f32 %0, %1, %2" : "=v"(r) : "v"(lo), "v"(hi)); return r; }
__device__ __forceinline__ int v_st(int k, int c) { const int kk = (k & ~0xC) | ((k & 4) << 1) | ((k & 8) >> 1); return ((kk >> 3) * 4 + (c >> 5)) * 512 + ((kk & 7) * 32 + (c & 31)) * 2; }
__device__ __forceinline__ int v_rd_base(int lane) { return ((lane & 3) << 3) | (((lane >> 2) & 3) << 6) | (((lane >> 4) & 1) << 5) | (((lane >> 5) & 1) << 8); }
constexpr int v_rd_off(int d0, int ks, int half) { return d0 * 512 + ks * 4096 + half * 2048; }
template <int OFF> __device__ __forceinline__ s16x4 tr_read(int vb) { s16x4 r; asm volatile("ds_read_b64_tr_b16 %0, %1 offset:%2" : "=&v"(r) : "v"(vb), "i"(OFF) : "memory"); return r; }
template <int D0> __device__ __forceinline__ void pv_one(f32x16& od, int vb, bf16x8 pa0, bf16x8 pa1, bf16x8 pa2, bf16x8 pa3) {
    const s16x4 l0 = tr_read<v_rd_off(D0, 0, 0)>(vb), h0 = tr_read<v_rd_off(D0, 0, 1)>(vb), l1 = tr_read<v_rd_off(D0, 1, 0)>(vb), h1 = tr_read<v_rd_off(D0, 1, 1)>(vb);
    const s16x4 l2 = tr_read<v_rd_off(D0, 2, 0)>(vb), h2 = tr_read<v_rd_off(D0, 2, 1)>(vb), l3 = tr_read<v_rd_off(D0, 3, 0)>(vb), h3 = tr_read<v_rd_off(D0, 3, 1)>(vb);
    asm volatile("s_waitcnt lgkmcnt(0)" ::: "memory"); ATT_SBAR();
#define ATT_PK(L, H) (bf16x8){L[0], L[1], L[2], L[3], H[0], H[1], H[2], H[3]}
    od = __builtin_amdgcn_mfma_f32_32x32x16_bf16(pa0, ATT_PK(l0, h0), od, 0, 0, 0);
    od = __builtin_amdgcn_mfma_f32_32x32x16_bf16(pa1, ATT_PK(l1, h1), od, 0, 0, 0);
    od = __builtin_amdgcn_mfma_f32_32x32x16_bf16(pa2, ATT_PK(l2, h2), od, 0, 0, 0);
    od = __builtin_amdgcn_mfma_f32_32x32x16_bf16(pa3, ATT_PK(l3, h3), od, 0, 0, 0);
#undef ATT_PK
}
__device__ __forceinline__ void attn_unit(const Ctx& c, unsigned char* lds, int xr0, int h, int kb, int NT, int wl, bool tailmask) {
    const int tid = c.tid, wid = c.wave, lane = c.lane, r32 = lane & 31, hi = lane >> 5;
    float* wsf = (float*)(lds + OFF_WS) + wid * 64; float* li_l = wsf; float* al_l = wsf + 32;
    float m_reg = -1e30f, l_reg = 0.f; f32x16 o[4] = {}; bf16x8 qr[12];
    {   const bf16* Qw = c.Q + (size_t)(xr0 + wid * 32 + r32) * QP;
        if (wl >= 0) {
#pragma unroll
            for (int d0 = 0; d0 < 8; ++d0) qr[d0] = *(const bf16x8*)(Qw + h * NOPE + d0 * 16 + hi * 8);
#pragma unroll
            for (int d0 = 0; d0 < 4; ++d0) qr[8 + d0] = *(const bf16x8*)(Qw + 2048 + h * ROPE + d0 * 16 + hi * 8);
        } else {
#pragma unroll
            for (int d0 = 0; d0 < 12; ++d0) qr[d0] = (bf16x8){0, 0, 0, 0, 0, 0, 0, 0};
        } }
    const int sr = tid >> 4, sc = (tid & 15) * 8, vst0 = v_st(sr, sc), vst1 = v_st(32 + sr, sc), rr = tid >> 3, rc = tid & 7;
    const int vb0 = (int)(uintptr_t)(lds + SHM_KN + SHM_KR) + v_rd_base(lane);
    bf16x8 sk0, sk1, sv0, sv1, skr;
    const bf16* Kg = c.KV + (size_t)kb * KVP + h * NOPE; const bf16* Vg = c.KV + (size_t)kb * KVP + 2048 + h * VH; const bf16* Rg = c.KPEA + (size_t)kb * ROPE;
#define ATT_SLOAD(k0) do { sk0 = *(const bf16x8*)(Kg + (size_t)((k0) + sr) * KVP + sc); sk1 = *(const bf16x8*)(Kg + (size_t)((k0) + 32 + sr) * KVP + sc); \
        sv0 = *(const bf16x8*)(Vg + (size_t)((k0) + sr) * KVP + sc); sv1 = *(const bf16x8*)(Vg + (size_t)((k0) + 32 + sr) * KVP + sc); \
        skr = *(const bf16x8*)(Rg + (size_t)((k0) + rr) * ROPE + rc * 8); } while (0)
#define ATT_SWRITE(b) do { unsigned char* B_ = lds + (b) * SHM_BUF; \
        *(bf16x8*)(B_ + ATT_KSWZ(sr, sc * 2)) = sk0; *(bf16x8*)(B_ + ATT_KSWZ(32 + sr, sc * 2)) = sk1; \
        *(bf16x8*)(B_ + SHM_KN + ATT_RSWZ(rr, rc)) = skr; \
        *(bf16x8*)(B_ + SHM_KN + SHM_KR + vst0) = sv0; *(bf16x8*)(B_ + SHM_KN + SHM_KR + vst1) = sv1; } while (0)
    ATT_SLOAD(0); ATT_SWRITE(0); __syncthreads();
    for (int j = 0; j < NT; ++j) {
        const int buf = j & 1;
        bf16x8 pa0, pa1, pa2, pa3;
        if (j + 1 < NT) ATT_SLOAD((j + 1) * 64);
        ATT_SBAR();
        if (j <= wl) {
            const unsigned char* Kn = lds + buf * SHM_BUF; const unsigned char* Kr = Kn + SHM_KN;
            f32x16 p0 = {}, p1 = {};
            int r32 = lane & 31, hi = lane >> 5; asm volatile("" : "+v"(r32), "+v"(hi));
#pragma unroll
            for (int d0 = 0; d0 < 8; ++d0) { const int cb = (d0 * 16 + hi * 8) * 2;
                const bf16x8 b0 = *(const bf16x8*)(Kn + ATT_KSWZ(r32, cb)), b1 = *(const bf16x8*)(Kn + ATT_KSWZ(32 + r32, cb));
                p0 = __builtin_amdgcn_mfma_f32_32x32x16_bf16(b0, qr[d0], p0, 0, 0, 0); p1 = __builtin_amdgcn_mfma_f32_32x32x16_bf16(b1, qr[d0], p1, 0, 0, 0);
                if ((d0 & 3) == 3) ATT_SBAR(); }
#pragma unroll
            for (int d0 = 0; d0 < 4; ++d0) { const int ch = d0 * 2 + hi;
                const bf16x8 b0 = *(const bf16x8*)(Kr + ATT_RSWZ(r32, ch)), b1 = *(const bf16x8*)(Kr + ATT_RSWZ(32 + r32, ch));
                p0 = __builtin_amdgcn_mfma_f32_32x32x16_bf16(b0, qr[8 + d0], p0, 0, 0, 0); p1 = __builtin_amdgcn_mfma_f32_32x32x16_bf16(b1, qr[8 + d0], p1, 0, 0, 0); }
            if (j == 0) {
#pragma unroll
                for (int r = 8; r < 16; ++r) p0[r] = -1e30f;
#pragma unroll
                for (int r = 0; r < 16; ++r) p1[r] = -1e30f;
            }
            if (tailmask && j == NT - 1) {
#pragma unroll
                for (int r = 0; r < 16; ++r) p1[r] = -1e30f;
            }
            float pmax = p0[0];
#pragma unroll
            for (int r = 1; r < 16; ++r) pmax = fmaxf(pmax, p0[r]);
#pragma unroll
            for (int r = 0; r < 16; ++r) pmax = fmaxf(pmax, p1[r]);
            { auto sw = __builtin_amdgcn_permlane32_swap(__float_as_uint(pmax), __float_as_uint(pmax), false, false); pmax = fmaxf(__uint_as_float(sw[0]), __uint_as_float(sw[1])); }
            float mn, alpha;
            if (__all(pmax - m_reg <= THR / ATTN_SCALE)) { mn = m_reg; alpha = 1.f; }
            else { mn = fmaxf(m_reg, pmax); alpha = __builtin_amdgcn_exp2f((m_reg - mn) * CEXP); m_reg = mn; }
            const float mnC = -mn * CEXP;
#pragma unroll
            for (int r = 0; r < 16; ++r) { p0[r] = __builtin_amdgcn_exp2f(fmaf(p0[r], CEXP, mnC)); p1[r] = __builtin_amdgcn_exp2f(fmaf(p1[r], CEXP, mnC)); }
            float ps = 0.f;
#pragma unroll
            for (int r = 0; r < 16; ++r) ps += p0[r] + p1[r];
            { auto sw = __builtin_amdgcn_permlane32_swap(__float_as_uint(ps), __float_as_uint(ps), false, false); ps = __uint_as_float(sw[0]) + __uint_as_float(sw[1]); }
            l_reg = l_reg * alpha + ps;
            if (__any(alpha < 1.f)) { if (hi == 0) al_l[r32] = alpha; asm volatile("s_waitcnt lgkmcnt(0)" ::: "memory");
#pragma unroll
                for (int d = 0; d < 4; ++d)
#pragma unroll
                    for (int r = 0; r < 16; ++r) o[d][r] *= al_l[crow(r, hi)]; }
#define ATT_PK4(P, BASE, OUT) do { unsigned a0 = cvtpk(P[BASE + 0], P[BASE + 1]), a1 = cvtpk(P[BASE + 2], P[BASE + 3]); \
        unsigned b0_ = cvtpk(P[BASE + 4], P[BASE + 5]), b1_ = cvtpk(P[BASE + 6], P[BASE + 7]); \
        auto r0 = __builtin_amdgcn_permlane32_swap(a0, b0_, false, false); auto r1 = __builtin_amdgcn_permlane32_swap(a1, b1_, false, false); \
        u32x4 w_ = {r0[0], r1[0], r0[1], r1[1]}; OUT = *reinterpret_cast<bf16x8*>(&w_); } while (0)
            ATT_PK4(p0, 0, pa0); ATT_PK4(p0, 8, pa1); ATT_PK4(p1, 0, pa2); ATT_PK4(p1, 8, pa3);
#undef ATT_PK4
            const int vb = vb0 + buf * SHM_BUF;
            pv_one<0>(o[0], vb, pa0, pa1, pa2, pa3); pv_one<1>(o[1], vb, pa0, pa1, pa2, pa3); pv_one<2>(o[2], vb, pa0, pa1, pa2, pa3); pv_one<3>(o[3], vb, pa0, pa1, pa2, pa3);
        }
        if (j + 1 < NT) ATT_SWRITE(buf ^ 1);
        __syncthreads();
    }
#undef ATT_SLOAD
#undef ATT_SWRITE
    if (wl >= 0) {
        int r32 = lane & 31, hi = lane >> 5; asm volatile("" : "+v"(r32), "+v"(hi));
        if (hi == 0) li_l[r32] = l_reg; asm volatile("s_waitcnt lgkmcnt(0)" ::: "memory");
        const int rowb = xr0 + wid * 32;
        bf16* stg = (bf16*)(lds + OFF_WS + 2048 + wid * 8192);
#pragma unroll
        for (int r = 0; r < 16; ++r) { const float il = __builtin_amdgcn_rcpf(li_l[crow(r, hi)]);
#pragma unroll
            for (int d0 = 0; d0 < 4; ++d0) stg[crow(r, hi) * 128 + d0 * 32 + r32] = (bf16)f2bf(o[d0][r] * il); }
        asm volatile("s_waitcnt lgkmcnt(0)" ::: "memory");
#pragma unroll
        for (int i = 0; i < 8; ++i) { const int idx = i * 64 + lane, row = idx >> 4, ch = idx & 15;
            const u32x4 ov = *(const u32x4*)(stg + row * 128 + ch * 8), zv = *(const u32x4*)(c.P + (size_t)(rowb + row) * NP + PC_ZA + h * VH + ch * 8);
            u32x4 w;
#pragma unroll
            for (int e = 0; e < 4; ++e) w[e] = pk2(bflo(ov[e]) * siluf_(bflo(zv[e])), bfhi(ov[e]) * siluf_(bfhi(zv[e])));
            *(u32x4*)(c.MIX + (size_t)(rowb + row) * DM + h * VH + ch * 8) = w; }
    }
    __syncthreads();
}
}


namespace ml {
using bf16x8 = __attribute__((ext_vector_type(8))) short;
using s16x4 = __attribute__((ext_vector_type(4))) short;
using f32x16 = __attribute__((ext_vector_type(16))) float;
typedef short v4i16_t __attribute__((ext_vector_type(4)));
constexpr int NCI = 560;
constexpr size_t SC_WI = 512 * 1024;
__device__ __forceinline__ int crow(int r, int hi) { return (r & 3) + 8 * (r >> 2) + 4 * hi; }
__device__ __forceinline__ void chunk_info(int ci, int& seq, int& c, bool& prompt, int& b, int& h, int& xr0, int& nreal) {
    if (ci < 528) { prompt = true; seq = ci / 33; c = ci % 33; b = seq >> 2; h = seq & 3; if (c == 0) { xr0 = XR_META; nreal = NMETA; } else { xr0 = b * SEQ + 64 * (c - 1); nreal = 64; } }
    else { prompt = false; seq = ci - 528; c = 0; b = seq >> 2; h = seq & 3; xr0 = XR_SAMPLE + b * LS; nreal = LS; }
}
__device__ __forceinline__ float scan_add(float v, int lane) {
#pragma unroll
    for (int o = 1; o < 64; o <<= 1) { const float t = __shfl_up(v, o); if (lane >= o) v += t; }
    return v;
}
__device__ __forceinline__ float scan_max(float v, int lane) {
#pragma unroll
    for (int o = 1; o < 64; o <<= 1) { const float t = __shfl_up(v, o); if (lane >= o) v = fmaxf(v, t); }
    return v;
}
constexpr int PA_P = 528, PA_Q = 0, PA_K = 64 * PA_P, PA_XS = 2 * 64 * PA_P, PA_MB = PA_XS + 256, PA_WS = PA_MB + 256, PA_SUM = PA_WS + 256, PA_MAX = PA_SUM + 256;
__device__ __forceinline__ void passA_item(const Ctx& c, LAS unsigned char* lds, bool prompt, int seq, int cc) {
    bf16* SPb = (bf16*)(c.ws + WS_SP); bf16* KPb = (bf16*)(c.ws + WS_KP); float* WIb = (float*)(c.ws + WS_SCAL + SC_WI);
    const int tid = c.tid, lane = c.lane, w = c.wave, r32 = lane & 31, hi = lane >> 5;
    const int b = seq >> 2, h = seq & 3, ci = prompt ? seq * 33 + cc : 528 + seq;
    const int xr0 = prompt ? (cc == 0 ? XR_META : b * SEQ + 64 * (cc - 1)) : XR_SAMPLE + b * LS, nreal = prompt ? (cc == 0 ? NMETA : 64) : LS;
#pragma unroll
    for (int k = 0; k < 4; ++k) { const int ch = tid + 512 * k, row = ch >> 5, cx = ch & 31;
        const u32x4 qv = *(const u32x4*)(c.P + (size_t)(xr0 + row) * NP + PC_MQ + h * DQK + cx * 8), kv = *(const u32x4*)(c.P + (size_t)(xr0 + row) * NP + PC_MK + h * DQK + cx * 8);
        *(LAS u32x4*)(lds + PA_Q + row * PA_P + cx * 16) = qv; *(LAS u32x4*)(lds + PA_K + row * PA_P + cx * 16) = kv; }
    if (w == 0) {
        float Brun = 0.f, Mx = -1e30f;
        if (prompt) { const float sl = lane < cc ? *(const LAS float*)(lds + PA_SUM + lane * 4) : 0.f, ml = lane < cc ? *(const LAS float*)(lds + PA_MAX + lane * 4) : -1e30f;
            const float incl = scan_add(sl, lane); Brun = __shfl(incl, 63); Mx = wave_max(lane < cc ? ml - (incl - sl) : -1e30f); }
        const float bi = c.b_ig[h], bfg = c.b_fg[h], m0 = prompt ? 0.f : c.state_m[b * MLH + h];
        const bool real = lane < nreal; float lf = 0.f, ig = -1e30f;
        if (real) { ig = c.G32[(size_t)(xr0 + lane) * GP + GC_MI + h] + bi; lf = logsigmoidf_(c.G32[(size_t)(xr0 + lane) * GP + GC_MF + h] + bfg); }
        const float Bs = Brun + scan_add(lf, lane), xs = real ? ig - Bs : -1e30f;
        const float mb0 = fmaxf(m0, Mx), mb = fmaxf(m0, fmaxf(Mx, scan_max(xs, lane))), ms = Bs + mb, mb31 = __shfl(mb, 31), mb63 = __shfl(mb, 63);
        const float mb_prev = lane < 32 ? mb0 : mb31, mb_end = lane < 32 ? mb31 : mb63;
        *(LAS float*)(lds + PA_XS + lane * 4) = xs; *(LAS float*)(lds + PA_MB + lane * 4) = mb; *(LAS float*)(lds + PA_WS + lane * 4) = real ? __expf(xs - mb_end) * 0.0625f : 0.f;
        WIb[ci * 64 + lane] = __expf(mb_prev - mb);
        if (real) c.MTOK[(size_t)(xr0 + lane) * 4 + h] = ms;
        if ((!prompt || cc == 32) && lane == 63) c.out[(prompt ? O_MP : O_MS) + b * MLH + h] = ms;
    }
    __syncthreads();
    bf16* sp = SPb + (size_t)ci * 4096;
    if (w < 2) {
        f32x16 acc = {};
        const LAS unsigned char* qa = lds + PA_Q + (32 * w + r32) * PA_P + hi * 16; const LAS unsigned char* ka = lds + PA_K + (32 * w + r32) * PA_P + hi * 16;
#pragma unroll
        for (int kk = 0; kk < 16; ++kk) acc = __builtin_amdgcn_mfma_f32_32x32x16_bf16(*(const LAS bf16x8*)(qa + kk * 32), *(const LAS bf16x8*)(ka + kk * 32), acc, 0, 0, 0);
        const float xsv = *(const LAS float*)(lds + PA_XS + (32 * w + r32) * 4);
#pragma unroll
        for (int r = 0; r < 16; ++r) { const int t0 = crow(r, hi); const float mbv = *(const LAS float*)(lds + PA_MB + (32 * w + t0) * 4);
            const float v = r32 <= t0 ? __expf(xsv - mbv) * acc[r] * 0.0625f : 0.f;
            sp[w * 1024 + t0 * 32 + r32] = (bf16)f2bf(v); }
    }
    bf16* kp = KPb + (size_t)ci * 16384;
#pragma unroll
    for (int k = 0; k < 4; ++k) { const int ch = tid + 512 * k, row = ch >> 5, cx = ch & 31; const float wv = *(const LAS float*)(lds + PA_WS + row * 4);
        const u32x4 kv = *(const LAS u32x4*)(lds + PA_K + row * PA_P + cx * 16);
        u32x4 o; o.x = pk2(bflo(kv.x) * wv, bfhi(kv.x) * wv); o.y = pk2(bflo(kv.y) * wv, bfhi(kv.y) * wv); o.z = pk2(bflo(kv.z) * wv, bfhi(kv.z) * wv); o.w = pk2(bflo(kv.w) * wv, bfhi(kv.w) * wv);
        *(u32x4*)(kp + row * 256 + cx * 8) = o; }
    __syncthreads();
}
__device__ __forceinline__ void passA(const Ctx& c, LAS unsigned char* lds) {
    const int lane = c.lane, w = c.wave, seq = c.blk & 15, slot = c.blk >> 4, b = seq >> 2, h = seq & 3;
    if (c.blk < 256) {
        const float bi = c.b_ig[h], bfg = c.b_fg[h];
        for (int cc = w; cc < 33; cc += 8) {
            const int xr0 = cc == 0 ? XR_META : b * SEQ + 64 * (cc - 1), nreal = cc == 0 ? NMETA : 64;
            float lf = 0.f, ig = -1e30f;
            if (lane < nreal) { ig = c.G32[(size_t)(xr0 + lane) * GP + GC_MI + h] + bi; lf = logsigmoidf_(c.G32[(size_t)(xr0 + lane) * GP + GC_MF + h] + bfg); }
            const float Bl = scan_add(lf, lane), mx = wave_max(lane < nreal ? ig - Bl : -1e30f), tot = __shfl(Bl, 63);
            if (lane == 0) { *(LAS float*)(lds + PA_SUM + cc * 4) = tot; *(LAS float*)(lds + PA_MAX + cc * 4) = mx; }
        }
        __syncthreads();
        for (int cc = slot; cc < 33; cc += 16) passA_item(c, lds, true, seq, cc);
        const int j = 255 - c.blk; if (j < 32) passA_item(c, lds, false, j, 0);
    }
}
constexpr int QT_P = 520, KT_P = 576, ST_P = 80;
constexpr int L_Q = 0, L_K = 32 * QT_P, L_V = L_K + 32 * KT_P, L_S = L_V + 32 * KT_P, L_W = L_S + 32 * ST_P, L_STAGE = L_W + 128, L_END = 2 * L_STAGE;
static_assert(L_END <= 150016 && L_STAGE % 16 == 0, "pass B LDS map must stay below the LDS control words");
__device__ __forceinline__ s16x4 vtr(const LAS unsigned char* p) { return __builtin_bit_cast(s16x4, __builtin_amdgcn_ds_read_tr16_b64_v4i16((LAS v4i16_t*)p)); }
__device__ __forceinline__ void passB_unit(const Ctx& c, LAS unsigned char* lds, int seq, bool prompt, int kind) {
    const int tid = c.tid, lane = c.lane, w = c.wave, r32 = lane & 31, hi = lane >> 5;
    const int b = seq >> 2, h = seq & 3, ci0 = prompt ? seq * 33 : 528 + seq;
    const bool ones = kind == 2; const int dv0 = (ones ? 0 : kind * 256) + 32 * w;
    const bool active = !ones || w == 0;
    const bf16* SPb = (const bf16*)(c.ws + WS_SP); const bf16* KPb = (const bf16*)(c.ws + WS_KP); const float* WIb = (const float*)(c.ws + WS_SCAL + SC_WI);
    f32x16 cacc[8];
    {   const float* sC = c.state_C + ((size_t)b * MLH + h) * DQK * DV; const float* sN = c.state_n + ((size_t)b * MLH + h) * DQK;
        unsigned lo_c = (unsigned)((4 * hi) * DV + dv0 + r32), lo_n = (unsigned)(4 * hi);
#pragma unroll
        for (int i = 0; i < 8; ++i) {
            asm volatile("" : "+v"(lo_c), "+v"(lo_n));
#pragma unroll
            for (int r = 0; r < 16; ++r) {
                float v = 0.f; const int dkc = 32 * i + (r & 3) + 8 * (r >> 2);
                if (!prompt) { if (!ones) v = sC[lo_c + dkc * DV]; else if (w == 0 && r32 == 0) v = sN[lo_n + dkc]; }
                cacc[i][r] = v; }
            __builtin_amdgcn_sched_barrier(0);
        } }
    const int NS = prompt ? 65 : 1;
    u32x4 sq0, sq1, sk0, sk1, sv0 = {0u, 0u, 0u, 0u}, sv1 = {0u, 0u, 0u, 0u}, ss = {0u, 0u, 0u, 0u}; float swi = 0.f;
#define ML_CC(k_) ((k_) == 0 ? 0 : ((k_) + 1) >> 1)
#define ML_JJ(k_) ((k_) == 0 ? 0 : ((k_) + 1) & 1)
#define ML_XR0(k_) ((prompt ? (ML_CC(k_) == 0 ? XR_META : b * SEQ + 64 * (ML_CC(k_) - 1)) : XR_SAMPLE + b * LS) + 32 * ML_JJ(k_))
#define ML_BAR() do { asm volatile("s_waitcnt lgkmcnt(0)" ::: "memory"); __builtin_amdgcn_s_barrier(); asm volatile("" ::: "memory"); } while (0)
#define ML_LOAD(k_) do { const int ci_ = ci0 + ML_CC(k_), jj_ = ML_JJ(k_), x0_ = ML_XR0(k_); int tq = tid; asm volatile("" : "+v"(tq)); \
        const int r0_ = tq >> 5, cx_ = tq & 31; \
        sq0 = *(const u32x4*)(c.P + (size_t)(x0_ + r0_) * NP + PC_MQ + h * DQK + cx_ * 8); sq1 = *(const u32x4*)(c.P + (size_t)(x0_ + 16 + r0_) * NP + PC_MQ + h * DQK + cx_ * 8); \
        sk0 = *(const u32x4*)(KPb + (size_t)ci_ * 16384 + (32 * jj_ + r0_) * 256 + cx_ * 8); sk1 = *(const u32x4*)(KPb + (size_t)ci_ * 16384 + (32 * jj_ + 16 + r0_) * 256 + cx_ * 8); \
        if (!ones) { sv0 = *(const u32x4*)(c.P + (size_t)(x0_ + r0_) * NP + PC_MV + h * DV + kind * 256 + cx_ * 8); sv1 = *(const u32x4*)(c.P + (size_t)(x0_ + 16 + r0_) * NP + PC_MV + h * DV + kind * 256 + cx_ * 8); } \
        if (tq < 128) ss = *(const u32x4*)(SPb + (size_t)ci_ * 4096 + jj_ * 1024 + (tq >> 2) * 32 + (tq & 3) * 8); if (tq < 32) swi = WIb[ci_ * 64 + 32 * jj_ + tq]; } while (0)
#define ML_WRITE(st_) do { int tq = tid; asm volatile("" : "+v"(tq)); const int r0_ = tq >> 5, cx_ = tq & 31; LAS unsigned char* B_ = lds + (st_) * L_STAGE; \
        *(LAS u32x2*)(B_ + L_Q + r0_ * QT_P + cx_ * 16) = (u32x2){sq0.x, sq0.y}; *(LAS u32x2*)(B_ + L_Q + r0_ * QT_P + cx_ * 16 + 8) = (u32x2){sq0.z, sq0.w}; \
        *(LAS u32x2*)(B_ + L_Q + (16 + r0_) * QT_P + cx_ * 16) = (u32x2){sq1.x, sq1.y}; *(LAS u32x2*)(B_ + L_Q + (16 + r0_) * QT_P + cx_ * 16 + 8) = (u32x2){sq1.z, sq1.w}; \
        *(LAS u32x4*)(B_ + L_K + r0_ * KT_P + cx_ * 16) = sk0; *(LAS u32x4*)(B_ + L_K + (16 + r0_) * KT_P + cx_ * 16) = sk1; \
        if (!ones) { *(LAS u32x4*)(B_ + L_V + r0_ * KT_P + cx_ * 16) = sv0; *(LAS u32x4*)(B_ + L_V + (16 + r0_) * KT_P + cx_ * 16) = sv1; } \
        if (tq < 128) *(LAS u32x4*)(B_ + L_S + (tq >> 2) * ST_P + (tq & 3) * 16) = ss; if (tq < 32) *(LAS float*)(B_ + L_W + tq * 4) = swi; } while (0)
    __syncthreads();
    if (ones) {
        for (int i = tid; i < 2 * 32 * 36; i += 512) { const int st = i / (32 * 36), row = (i % (32 * 36)) / 36, ch = i % 36; *(LAS u32x4*)(lds + st * L_STAGE + L_V + row * KT_P + ch * 16) = (u32x4){ch == 0 ? 0x3F80u : 0u, 0u, 0u, 0u}; }
    }
    ML_LOAD(0); ML_WRITE(0);
    ML_BAR();
    for (int k = 0; k < NS; ++k) {
        const int xr0 = ML_XR0(k), nreal = (prompt && k == 0) ? NMETA : 32;
        LAS unsigned char* const S_ = lds + (k & 1) * L_STAGE;
        if (k + 1 < NS) ML_LOAD(k + 1);
        __builtin_amdgcn_sched_barrier(0);
        if (active) {
            int lq = lane; asm volatile("" : "+v"(lq)); const int r32 = lq & 31, hi = lq >> 5;
            f32x16 hacc = {};
            u32x2 qa[2][2];
#define ML_QLD(n_) do { const LAS unsigned char* qp = S_ + L_Q + r32 * QT_P + (16 * (n_) + 4 * hi) * 2; qa[(n_) & 1][0] = *(const LAS u32x2*)qp; qa[(n_) & 1][1] = *(const LAS u32x2*)(qp + 16); } while (0)
            ML_QLD(0);
#pragma unroll
            for (int n = 0; n < 16; ++n) {
                const int i = n >> 1, s = n & 1;
                if (n + 1 < 16) ML_QLD(n + 1);
                u32x4 cw; cw.x = pg8::cvt_pk_bf16(cacc[i][8 * s + 0], cacc[i][8 * s + 1]); cw.y = pg8::cvt_pk_bf16(cacc[i][8 * s + 2], cacc[i][8 * s + 3]);
                cw.z = pg8::cvt_pk_bf16(cacc[i][8 * s + 4], cacc[i][8 * s + 5]); cw.w = pg8::cvt_pk_bf16(cacc[i][8 * s + 6], cacc[i][8 * s + 7]);
                const bf16x8 cf = __builtin_bit_cast(bf16x8, cw);
                const bf16x8 qf = __builtin_bit_cast(bf16x8, (u32x4){qa[n & 1][0].x, qa[n & 1][0].y, qa[n & 1][1].x, qa[n & 1][1].y});
                hacc = __builtin_amdgcn_mfma_f32_32x32x16_bf16(qf, cf, hacc, 0, 0, 0);
                __builtin_amdgcn_sched_barrier(0);
            }
#undef ML_QLD
#pragma unroll
            for (int r = 0; r < 16; ++r) hacc[r] *= *(const LAS float*)(S_ + L_W + crow(r, hi) * 4);
            const int troff = (8 * hi + ((lq & 15) >> 2)) * KT_P + (16 * ((lq >> 4) & 1) + 4 * (lq & 3)) * 2;
            bf16x8 vf[2];
#pragma unroll
            for (int kk = 0; kk < 2; ++kk) { const LAS unsigned char* vp = S_ + L_V + troff + (16 * kk) * KT_P + (32 * w) * 2;
                const s16x4 lo = vtr(vp), hi4 = vtr(vp + 4 * KT_P); vf[kk] = (bf16x8){lo[0], lo[1], lo[2], lo[3], hi4[0], hi4[1], hi4[2], hi4[3]}; }
#pragma unroll
            for (int kk = 0; kk < 2; ++kk) { const bf16x8 sf = *(const LAS bf16x8*)(S_ + L_S + r32 * ST_P + (16 * kk + 8 * hi) * 2);
                hacc = __builtin_amdgcn_mfma_f32_32x32x16_bf16(sf, vf[kk], hacc, 0, 0, 0); }
            {   float* nb = c.NUM + (size_t)xr0 * 2048 + h * DV; float* db = c.DEN + (size_t)xr0 * 4 + h;
                unsigned lo_n = (unsigned)((4 * hi) * 2048 + dv0 + r32), lo_d = (unsigned)((4 * hi) * 4);
                asm volatile("" : "+v"(lo_n), "+v"(lo_d));
#pragma unroll
                for (int r = 0; r < 16; ++r) { const int tc = (r & 3) + 8 * (r >> 2), t = tc + 4 * hi;
                    if (t < nreal) { if (!ones) nb[lo_n + tc * 2048] = hacc[r]; else if (r32 == 0) db[lo_d + tc * 4] = hacc[r]; } }
                __builtin_amdgcn_sched_barrier(0); }
            const float decay = *(const LAS float*)(S_ + L_W + 31 * 4);
            s16x4 ka[3][2];
#define ML_KLD(n_) do { const LAS unsigned char* kp_ = S_ + L_K + troff + (16 * ((n_) & 1)) * KT_P + (32 * ((n_) >> 1)) * 2; ka[(n_) % 3][0] = vtr(kp_); ka[(n_) % 3][1] = vtr(kp_ + 4 * KT_P); } while (0)
            ML_KLD(0); ML_KLD(1);
#pragma unroll
            for (int n = 0; n < 16; ++n) {
                const int i = n >> 1, kk = n & 1;
                if (n + 2 < 16) ML_KLD(n + 2);
                if (kk == 0) {
#pragma unroll
                    for (int r = 0; r < 16; ++r) cacc[i][r] *= decay; }
                const bf16x8 kf = (bf16x8){ka[n % 3][0][0], ka[n % 3][0][1], ka[n % 3][0][2], ka[n % 3][0][3], ka[n % 3][1][0], ka[n % 3][1][1], ka[n % 3][1][2], ka[n % 3][1][3]};
                cacc[i] = __builtin_amdgcn_mfma_f32_32x32x16_bf16(kf, vf[kk], cacc[i], 0, 0, 0);
                __builtin_amdgcn_sched_barrier(0);
            }
#undef ML_KLD
        }
        if (k + 1 < NS) ML_WRITE((k + 1) & 1);
        ML_BAR();
    }
#undef ML_CC
#undef ML_JJ
#undef ML_XR0
#undef ML_BAR
#undef ML_LOAD
#undef ML_WRITE
    if (active) {
        float* oc = c.out + (prompt ? O_CP : O_CS) + ((size_t)b * MLH + h) * DQK * DV; float* on = c.out + (prompt ? O_NP : O_NS) + ((size_t)b * MLH + h) * DQK;
        unsigned lo_c = (unsigned)((4 * hi) * DV + dv0 + r32), lo_n = (unsigned)(4 * hi);
#pragma unroll
        for (int i = 0; i < 8; ++i) {
            asm volatile("" : "+v"(lo_c), "+v"(lo_n));
#pragma unroll
            for (int r = 0; r < 16; ++r) { const int dkc = 32 * i + (r & 3) + 8 * (r >> 2);
                if (!ones) oc[lo_c + dkc * DV] = cacc[i][r]; else if (r32 == 0) on[lo_n + dkc] = cacc[i][r]; }
            __builtin_amdgcn_sched_barrier(0);
        }
    }
    __syncthreads();
}
}

__device__ __forceinline__ void phase5(const Ctx& c) {
    for (int it = c.gw; it < XR_OUT * MLH; it += c.NGW) {
        const int r = it >> 2, h = it & 3;
        const float den = c.DEN[(size_t)r * 4 + h], m = c.MTOK[(size_t)r * 4 + h];
        const float inv = 1.f / fmaxf(fabsf(den), __expf(-m));
        const f32x4* np = (const f32x4*)(c.NUM + (size_t)r * 2048 + h * DV) + 2 * c.lane;
        f32x4 a = np[0], b = np[1]; a *= inv; b *= inv;
        const float ss = wave_sum((a.x * a.x + a.y * a.y) + (a.z * a.z + a.w * a.w) + (b.x * b.x + b.y * b.y) + (b.z * b.z + b.w * b.w));
        const float rs = rsqrtf(ss * (1.f / DV) + EPS);
        const f32x4 g0 = ((const f32x4*)(c.ml_out_norm + h * DV))[2 * c.lane], g1 = ((const f32x4*)(c.ml_out_norm + h * DV))[2 * c.lane + 1];
        const u32x4 mo = ((const u32x4*)(c.P + (size_t)r * NP + PC_MO + h * DV))[c.lane], zb = ((const u32x4*)(c.P + (size_t)r * NP + PC_ZB + h * DV))[c.lane];
        float v[8] = {a.x * rs * g0.x, a.y * rs * g0.y, a.z * rs * g0.z, a.w * rs * g0.w, b.x * rs * g1.x, b.y * rs * g1.y, b.z * rs * g1.z, b.w * rs * g1.w};
        u32x4 o;
#pragma unroll
        for (int e = 0; e < 4; ++e) { const float x0 = v[2 * e] * sigmoidf_(bflo(mo[e])) * siluf_(bflo(zb[e])), x1 = v[2 * e + 1] * sigmoidf_(bfhi(mo[e])) * siluf_(bfhi(zb[e])); o[e] = pk2(x0, x1); }
        ((u32x4*)(c.MIX + (size_t)r * DM + 2048 + h * DV))[c.lane] = o;
    }
}

__device__ __forceinline__ Ctx make_ctx(const Args& a) {
    Ctx c;
    c.x_prompt = a.in[0]; c.x_sample = a.in[1]; c.cache_ckv = a.in[2]; c.cache_kpe = a.in[3]; c.state_C = a.in[4]; c.state_n = a.in[5]; c.state_m = a.in[6]; c.meta = a.in[7];
    c.norm_gain = a.in[8]; c.w_in = a.in[9]; c.b_ig = a.in[10]; c.b_fg = a.in[11]; c.q_a_norm = a.in[12]; c.w_q_up = a.in[13]; c.q_nope_norm = a.in[14]; c.q_rope_norm = a.in[15];
    c.kv_a_norm = a.in[16]; c.k_rope_norm = a.in[17]; c.w_kv_up = a.in[18]; c.k_nope_norm = a.in[19]; c.ml_out_norm = a.in[20]; c.w_out = a.in[21];
    c.out = a.out; c.ws = a.ws;
    c.XN = (bf16*)(a.ws + WS_XN); c.P = (bf16*)(a.ws + WS_P); c.CQN = (bf16*)(a.ws + WS_CQN); c.CKVA = (bf16*)(a.ws + WS_CKVA); c.KPEA = (bf16*)(a.ws + WS_KPEA);
    c.Q = (bf16*)(a.ws + WS_Q); c.KV = (bf16*)(a.ws + WS_KV); c.MIX = (bf16*)(a.ws + WS_MIX);
    c.G32 = (float*)(a.ws + WS_G32); c.NUM = (float*)(a.ws + WS_NUM); c.DEN = (float*)(a.ws + WS_SCAL + SC_DEN); c.MTOK = (float*)(a.ws + WS_SCAL + SC_MTOK); c.CST = (float*)(a.ws + WS_CST);
    c.tid = threadIdx.x; c.lane = c.tid & 63; c.wave = __builtin_amdgcn_readfirstlane(c.tid >> 6); c.nblk = gridDim.x; c.blk = blockIdx.x; c.gw = c.blk * 8 + c.wave; c.NGW = c.nblk * 8;
    return c;
}

constexpr int LDS_BYTES = 150528, MISC_OFF = 150016;
constexpr int CW_BAR = 4096, CW_QUEUE = 64;
__global__ void __launch_bounds__(512, 2) mk(Args a) {
    extern __shared__ __attribute__((aligned(16))) unsigned char lds[];
    const int lo = a.ph_lo, hi = a.ph_hi;
    volatile LAS unsigned* MISC = (volatile LAS unsigned*)((LAS unsigned char*)lds + MISC_OFF);
    if (threadIdx.x < 16) MISC[threadIdx.x] = 0u;
    __syncthreads();
    const XcdBarrier xbar = xcd_barrier_post((unsigned*)(a.ws + WS_CTL) + CW_BAR, MISC + 8);
#define IN(k) (lo <= (k) && (k) < hi)
#define SEAM(k) do { if (IN(k) && IN((k) + 1)) xcd_barrier(xbar); } while (0)
    if (IN(0)) { const Ctx c = make_ctx(a); phase0(c);
        LAS unsigned* scr = (LAS unsigned*)((LAS unsigned char*)lds) + c.wave * 2112;
        {   static_assert(RO_PRE == 2 && XR_PAD == 8704, "phase-0 balance is written for 3584 items and 8704 rows on 2048 waves");
            constexpr int NB = RO_TPR * 4, NBA = NPT / 64, NIR = (DM / 64) * NB;
#define P0_ITEM(it_) do { const int it__ = (it_), r__ = it__ / NIR, rem__ = it__ % NIR; transpose_item(c.w_in, IN_COLS, DM, (bf16*)(a.ws + WS_WIN), scr, (rem__ / NB) * NBA + NB * r__ + rem__ % NB, NBA, c.lane, cmap_win); } while (0)
            if (c.NGW == 2048) { if (c.gw >= 512) { P0_ITEM(c.gw - 512); P0_ITEM(c.gw - 512 + 1536); } else P0_ITEM(3072 + c.gw); }
            else for (int it = c.gw; it < RO_PRE * NIR; it += c.NGW) P0_ITEM(it);
#undef P0_ITEM
        }
        __syncthreads(); }
    SEAM(0);
    if (IN(1)) {
        const Ctx c = make_ctx(a);
        pg8::Gemm g{c.XN, (const bf16*)(a.ws + WS_WIN), XR_PAD, NPT, DM}; RoundOrder S; S.init(c.blk, (unsigned*)(a.ws + WS_CTL) + CW_ROUND, (LAS unsigned*)((LAS unsigned char*)lds + 139264) + c.wave * 64);
        EpiProj E{c.P, c.G32};
        pg8::gemm_phase<EpiProj, RoundOrder, true, true>((LAS unsigned char*)lds, g, S, E);
        if (c.blk >= RO_GEMM) {
            LAS unsigned* scr = (LAS unsigned*)((LAS unsigned char*)lds) + c.wave * 2112;
            for (int r = RO_PRE; r < 7; ++r) {
                convert_win_round(c.w_in, (bf16*)(a.ws + WS_WIN), scr, r, (c.blk - RO_GEMM) * 8 + c.wave, RO_NEED, c.lane);
                __builtin_amdgcn_fence(__ATOMIC_RELEASE, "agent");
                if (c.lane == 0) __hip_atomic_fetch_add((unsigned*)(a.ws + WS_CTL) + CW_ROUND + 32 * r, 1u, __ATOMIC_RELAXED, __HIP_MEMORY_SCOPE_AGENT);
            }
        }
        {   LAS unsigned* scr = (LAS unsigned*)((LAS unsigned char*)lds) + c.wave * 2112;
            constexpr int NQ = (QLORA / 64) * (QP / 64), NKVI = (KVLORA / 64) * (KVP / 64), NO = (DM / 64) * (DM / 64), NALL = NQ + NKVI + NO;
            unsigned* qw = (unsigned*)(a.ws + WS_CTL) + CW_QUEUE + 192;
            for (;;) {
                int base = 0; if (c.lane == 0) base = (int)__hip_atomic_fetch_add(qw, 8u, __ATOMIC_RELAXED, __HIP_MEMORY_SCOPE_AGENT);
                base = __builtin_amdgcn_readfirstlane(base); if (base >= NALL) break;
                for (int it = base; it < base + 8 && it < NALL; ++it) {
                    if (it < NQ) transpose_item<true>(c.w_q_up, 3072, QLORA, (bf16*)(a.ws + WS_WQ), scr, it, QP / 64, c.lane, cmap_wq);
                    else if (it < NQ + NKVI) transpose_item(c.w_kv_up, 4096, KVLORA, (bf16*)(a.ws + WS_WKV), scr, it - NQ, KVP / 64, c.lane, cmap_wkv);
                    else transpose_item(c.w_out, DM, DM, (bf16*)(a.ws + WS_WOUT), scr, it - NQ - NKVI, DM / 64, c.lane, cmap_id);
                }
            }
            __syncthreads(); }
    }
    SEAM(1);
    if (IN(2)) { const Ctx c = make_ctx(a); phase2_rows(c);
        ml::passA(c, (LAS unsigned char*)lds);
    }
    SEAM(2);
    if (IN(3)) {
        const Ctx c = make_ctx(a);
        { pg8::Gemm g{c.CQN, (const bf16*)(a.ws + WS_WQ), XR_OUT, QP, QLORA}; pg8::StaticOrder S; S.init(XR_OUT, QP, c.nblk, c.blk);
          EpiQ E{a.ws, (LAS float*)((LAS unsigned char*)lds + 131072)}; pg8::gemm_phase<EpiQ, pg8::StaticOrder, true, true>((LAS unsigned char*)lds, g, S, E); }
        { pg8::Gemm g{c.CKVA, (const bf16*)(a.ws + WS_WKV), NKR, KVP, KVLORA}; SplitOrder S; S.init(NKR, KVP, c.nblk, c.blk);
          EpiKV E{c.KV, c.k_nope_norm, (LAS float*)((LAS unsigned char*)lds + 131072)}; pg8::gemm_phase<EpiKV, SplitOrder, true, true>((LAS unsigned char*)lds, g, S, E); }
    }
    SEAM(3);
#define POP(word) do { if (threadIdx.x == 0) MISC[0] = __hip_atomic_fetch_add((unsigned*)(a.ws + WS_CTL) + (word), 1u, __ATOMIC_RELAXED, __HIP_MEMORY_SCOPE_AGENT); \
        __syncthreads(); u = (int)MISC[0]; __syncthreads(); } while (0)
    if (IN(5)) { const Ctx c = make_ctx(a);
        for (;;) { int u; POP(CW_QUEUE); if (u >= 48) break;
            if (u < 32) ml::passB_unit(c, (LAS unsigned char*)lds, u >> 1, true, u & 1); else ml::passB_unit(c, (LAS unsigned char*)lds, u - 32, true, 2); }
    }
    if (IN(5)) { const Ctx c = make_ctx(a);
        for (;;) { int u; POP(CW_QUEUE + 64); if (u >= 640) break;
            if (u < 512) { const int qb = 7 - (u >> 6), bh = u & 63, b = bh >> 4, h = bh & 15;
                att::attn_unit(c, lds, b * SEQ + 256 * qb, h, b * KRP, 4 * qb + 5, 4 * qb + 1 + (c.wave >> 1), false); }
            else { const int t = u - 512, b = t >> 4, h = t & 15;
                att::attn_unit(c, lds, XR_SAMPLE + b * LS, h, KR_SAMPLE0 + b * KRS, 18, c.wave == 0 ? 17 : -1, true); } }
    }
    if (IN(5)) { const Ctx c = make_ctx(a);
        for (;;) { int u; POP(CW_QUEUE + 128); if (u >= 96) break; ml::passB_unit(c, (LAS unsigned char*)lds, u / 3, false, u % 3); }
    }
#undef POP
    SEAM(5);
    if (IN(6)) { const Ctx c = make_ctx(a); phase5(c); }
    SEAM(6);
    if (IN(7)) {
        const Ctx c = make_ctx(a);
        pg8::Gemm g{c.MIX, (const bf16*)(a.ws + WS_WOUT), XR_SAMPLE, DM, DM}; pg8::StaticOrder S; S.init(XR_SAMPLE, DM, c.nblk, c.blk);
        EpiY E{c.x_prompt, c.x_sample, c.out};
        const bool first = (c.blk >> 3) & 1;
        if (first) skinny_out(c, (LAS unsigned char*)lds, (const bf16*)(a.ws + WS_WOUT));
        pg8::gemm_phase<EpiY, pg8::StaticOrder, true, true>((LAS unsigned char*)lds, g, S, E);
        if (!first) skinny_out(c, (LAS unsigned char*)lds, (const bf16*)(a.ws + WS_WOUT));
    }
#undef IN
#undef SEAM
}

extern "C" void kernel_launch(void* const* d_in, const int* in_sizes, int n_in, void* d_out, int out_size, void* d_ws, size_t ws_size, hipStream_t stream) {
    static int grid = 0;
    if (grid == 0) {
        if (n_in != 22 || out_size != (int)O_END || ws_size < WS_END) { fprintf(stderr, "kernel_launch: unexpected shapes: n_in %d out %d ws %zu (need %zu)\n", n_in, out_size, ws_size, (size_t)WS_END); grid = -1; return; }
        int dev = 0, cus = 0, per = 0; hipGetDevice(&dev); hipDeviceGetAttribute(&cus, hipDeviceAttributeMultiprocessorCount, dev);
        hipFuncSetAttribute((const void*)mk, hipFuncAttributeMaxDynamicSharedMemorySize, LDS_BYTES);
        hipOccupancyMaxActiveBlocksPerMultiprocessor(&per, (const void*)mk, 512, LDS_BYTES);
        grid = cus * per; fprintf(stderr, "kernel_launch: cus %d per_cu %d grid %d ws %zu\n", cus, per, grid, ws_size);
        if (grid != 256) { fprintf(stderr, "kernel_launch: this kernel is laid out for a 256-workgroup grid (one per CU); got %d\n", grid); grid = -1; return; }
    }
    if (grid < 0) return;
    if (hipMemsetAsync((char*)d_ws + WS_CTL, 0, 1 * MiB, stream) != hipSuccess) { fprintf(stderr, "kernel_launch: hipMemsetAsync failed\n"); return; }
    Args a{};
    for (int i = 0; i < 22; ++i) a.in[i] = (const float*)d_in[i];
    a.out = (float*)d_out; a.ws = (unsigned char*)d_ws; a.ph_lo = 0; a.ph_hi = 8;
    void* args[] = {&a};
    hipError_t e = hipLaunchCooperativeKernel((const void*)mk, dim3(grid), dim3(512), args, LDS_BYTES, stream);
    if (e != hipSuccess) fprintf(stderr, "kernel_launch: cooperative launch failed: %s (grid %d)\n", hipGetErrorString(e), grid);
}
```

```cpp
#include <hip/hip_runtime.h>
#include <hip/hip_cooperative_groups.h>
#include <cstdio>
#include <cstdint>
namespace cg = cooperative_groups;

constexpr int DM = 4096, NB = 4, SEQ = 2048, NMETA = 16, TP = NMETA + SEQ, NSB = 8, LS = 32, PAST = 1024;
constexpr int QLORA = 1536, KVLORA = 512, ROPE = 64, NOPE = 128, VH = 128, HA = 16;
constexpr int MLH = 4, DQK = 256, DV = 512;
constexpr int IN_COLS = 12360;
constexpr float EPS = 1e-6f;
constexpr int XR_SAMPLE = 8192, XR_META = 8448, XR_REAL = 8464, XR_PAD = 8704, XR_OUT = 8448;
constexpr int NP = 12288, NPT = 12544;
constexpr int PC_CQ = 0, PC_CKV = 1536, PC_MQ = 2048, PC_MK = 3072, PC_MV = 4096, PC_MO = 6144, PC_ZA = 8192, PC_ZB = 10240;
constexpr int GP = 256, GC_KPE = 0, GC_MI = 64, GC_MF = 68;
constexpr int KRP = 2112, KRS = 1152, KR_SAMPLE0 = NB * KRP, NKR = KR_SAMPLE0 + NSB * KRS;
constexpr int QP = 3072, KVP = 4096;
constexpr float ATTN_SCALE = 0.07216878364870322f;
constexpr long O_YP = 0, O_YS = 33554432, O_CKVP = 34603008, O_KPEP = 38830080, O_CP = 39358464, O_NP = 41455616, O_MP = 41459712,
               O_CKVS = 41459728, O_KPES = 41590800, O_CS = 41607184, O_NS = 45801488, O_MS = 45809680, O_END = 45809712;
constexpr size_t MiB = 1u << 20;
constexpr size_t WS_CTL = 0, WS_WIN = 2 * MiB, WS_XN = 100 * MiB, WS_P = 168 * MiB, WS_G32 = 377 * MiB, WS_WQ = 386 * MiB, WS_WKV = 395 * MiB,
                 WS_WOUT = 399 * MiB, WS_CQN = 431 * MiB, WS_CKVA = 456 * MiB, WS_KPEA = 474 * MiB, WS_Q = 477 * MiB, WS_KV = 527 * MiB,
                 WS_SP = 665 * MiB, WS_KP = 670 * MiB, WS_SCAL = 688 * MiB, WS_CST = 690 * MiB, WS_END = 716 * MiB;
constexpr size_t WS_NUM = WS_WIN;
constexpr size_t WS_MIX = WS_XN;
constexpr size_t SC_DEN = 0, SC_MTOK = 256 * 1024, SC_TAB = 1024 * 1024, SC_GAIN = 1024 * 1024 + 768 * 1024;

#define RPOS(l) ((((l) & 31) << 1) | ((l) >> 5))
typedef unsigned short bf16;
typedef float f32x4 __attribute__((ext_vector_type(4)));
typedef unsigned u32x4 __attribute__((ext_vector_type(4)));
typedef unsigned u32x2 __attribute__((ext_vector_type(2)));

__device__ __forceinline__ unsigned f2bf(float f) { unsigned u = __builtin_bit_cast(unsigned, f); return (u + 0x7fffu + ((u >> 16) & 1u)) >> 16; }
__device__ __forceinline__ unsigned pk2(float lo, float hi) { return f2bf(lo) | (f2bf(hi) << 16); }
__device__ __forceinline__ float bf2f(unsigned short b) { return __builtin_bit_cast(float, (unsigned)b << 16); }
__device__ __forceinline__ float bflo(unsigned w) { return __builtin_bit_cast(float, w << 16); }
__device__ __forceinline__ float bfhi(unsigned w) { return __builtin_bit_cast(float, w & 0xffff0000u); }
__device__ __forceinline__ float wave_sum(float v) {
#pragma unroll
    for (int o = 1; o < 64; o <<= 1) v += __shfl_xor(v, o);
    return v;
}
__device__ __forceinline__ float wave_max(float v) {
#pragma unroll
    for (int o = 1; o < 64; o <<= 1) v = fmaxf(v, __shfl_xor(v, o));
    return v;
}
__device__ __forceinline__ float sigmoidf_(float x) { return __builtin_amdgcn_rcpf(1.f + __expf(-x)); }
__device__ __forceinline__ float siluf_(float x) { return x * __builtin_amdgcn_rcpf(1.f + __expf(-x)); }
__device__ __forceinline__ float logsigmoidf_(float x) { return fminf(x, 0.f) - log1pf(__expf(-fabsf(x))); }

struct Args { const float* in[22]; float* out; unsigned char* ws; int ph_lo, ph_hi; };

struct Ctx {
    const float *x_prompt, *x_sample, *cache_ckv, *cache_kpe, *state_C, *state_n, *state_m, *meta, *norm_gain, *w_in, *b_ig, *b_fg, *q_a_norm, *w_q_up,
        *q_nope_norm, *q_rope_norm, *kv_a_norm, *k_rope_norm, *w_kv_up, *k_nope_norm, *ml_out_norm, *w_out;
    float* out; unsigned char* ws;
    bf16 *XN, *P, *CQN, *CKVA, *KPEA, *Q, *KV, *MIX;
    float *G32, *DEN, *MTOK, *CST; bf16* NUM;
    int tid, lane, wave, gw, NGW, nblk, blk;
};

__device__ __forceinline__ const float* xrow_ptr(const Ctx& c, int r) {
    return r < XR_SAMPLE ? c.x_prompt + (size_t)r * DM : (r < XR_META ? c.x_sample + (size_t)(r - XR_SAMPLE) * DM : c.meta + (size_t)(r - XR_META) * DM);
}
__device__ __forceinline__ int xrow_pos(int r) { return r < XR_SAMPLE ? NMETA + (r & (SEQ - 1)) : (r < XR_META ? NMETA + PAST + ((r - XR_SAMPLE) & (LS - 1)) : r - XR_META); }

namespace pg8 {
#define PG8_LAS __attribute__((address_space(3)))
typedef unsigned short bf16_t;
typedef short bf16x8 __attribute__((ext_vector_type(8)));
typedef float f32x4 __attribute__((ext_vector_type(4)));
typedef unsigned u32x4 __attribute__((ext_vector_type(4)));
constexpr int BM = 256, BK = 64, HALF = 128, HTB = HALF * BK * 2  , STAGE_BYTES = 8 * HTB, NXCD = 8, WGM = 8;

__host__ __device__ __forceinline__ int lds_byte(int r, int c) { const int st = (r >> 4) * 2 + (c >> 5), rr = r & 15, cc = c & 31, ob = rr * 64 + cc * 2; return st * 1024 + (ob ^ (((ob >> 9) & 1) << 5)); }
__host__ __device__ __forceinline__ void stage_rc(int b, int& R, int& C) { const int st = b / 1024, sb = b % 1024, swz = sb ^ (((sb >> 9) & 1) << 5); R = (st >> 1) * 16 + swz / 64; C = (st & 1) * 32 + (swz % 64) / 2; }
__host__ __device__ __forceinline__ int perm32(int rho) { const int n = rho >> 4, i = rho & 15; return 8 * (i >> 2) + 4 * n + (i & 3); }

struct Unit { int pm, pn; };
struct Gemm { const bf16_t* A; const bf16_t* Bt; int M, N, K; };

struct StaticOrder {
    int nM, nN, nwg, G, c;
    __host__ __device__ void init(int M, int N, int G_, int c_) { nM = M / BM; nN = N / BM; nwg = nM * nN; G = G_; c = c_; }
    __host__ __device__ bool next(int i, Unit& u) const {
        const long L = (long)i * G + c; if (L >= nwg) return false;
        int wgid = (int)L; { const int q = nwg / NXCD, r = nwg % NXCD, xcd = wgid % NXCD, off = wgid / NXCD; wgid = (xcd < r ? xcd * (q + 1) : r * (q + 1) + (xcd - r) * q) + off; }
        const int nig = WGM * nN, gid = wgid / nig, fm = gid * WGM, gsz = (nM - fm) < WGM ? (nM - fm) : WGM;
        u.pm = fm + ((wgid % nig) % gsz); u.pn = (wgid % nig) / gsz; return true;
    }
    __device__ __forceinline__ unsigned peek(const Unit&) const { return 0u; }
    __device__ __forceinline__ void a_ready(const Unit&, unsigned) const {}
    __device__ __forceinline__ void done(const Unit&) const {}
};

__device__ __forceinline__ unsigned cvt_pk_bf16(float lo, float hi) { unsigned r; asm volatile("v_cvt_pk_bf16_f32 %0, %1, %2" : "=v"(r) : "v"(lo), "v"(hi)); return r; }
template <class Epi, class Sched, bool ALIGN_EPI = false, bool SP2 = false>
__device__ __forceinline__ void gemm_phase(PG8_LAS unsigned char* lds, const Gemm g, const Sched& S, const Epi& E) {
    const int tid = threadIdx.x, wid = __builtin_amdgcn_readfirstlane(tid >> 6), lane = tid & 63, wr = wid >> 2, wc = wid & 3, fr = lane & 15, fq = lane >> 4;
    const int K = g.K, nt = K / BK;
    unsigned voffA[2], voffB[2];
#pragma unroll
    for (int i = 0; i < 2; ++i) { int R, C; stage_rc(tid * 16 + i * 8192, R, C); const int Rb = Epi::PERM ? ((R & ~31) + perm32(R & 31)) : R;
        voffA[i] = (unsigned)(R * K + C) * 2u; voffB[i] = (unsigned)(Rb * K + C) * 2u; }
    const size_t kstep = (size_t)(BK * 2);
    const size_t hstep = (size_t)HALF * K * 2;
    const size_t tstep = 2 * hstep;
    const unsigned ldsw = (unsigned)wid * 1024u;
    const int aoff = lds_byte(wr * 64 + fr, fq * 8), boff = lds_byte(wc * 32 + fr, fq * 8);
#define PG8_SA(b, h) (((b) * 2 + (h)) * HTB)
#define PG8_SB(b, h) ((4 + (b) * 2 + (h)) * HTB)
#define PG8_STAGE(bufoff, gbase, voff) do { _Pragma("unroll") for (int _i = 0; _i < 2; ++_i) \
        __builtin_amdgcn_global_load_lds((const unsigned*)((const char*)(gbase) + (voff)[_i]), (PG8_LAS unsigned*)(lds + (bufoff) + ldsw + _i * 8192), 16, 0, 0); } while (0)
#define PG8_LDA(dst, b, h) do { _Pragma("unroll") for (int m = 0; m < 4; ++m) _Pragma("unroll") for (int k = 0; k < 2; ++k) dst[m][k] = *(const PG8_LAS bf16x8*)(lds + PG8_SA(b, h) + aoff + m * 2048 + k * 1024); } while (0)
#define PG8_LDB(dst, b, h) do { _Pragma("unroll") for (int n = 0; n < 2; ++n) _Pragma("unroll") for (int k = 0; k < 2; ++k) dst[n][k] = *(const PG8_LAS bf16x8*)(lds + PG8_SB(b, h) + boff + n * 2048 + k * 1024); } while (0)
#define PG8_MMA(ai, bj, At, Bt) do { __builtin_amdgcn_s_setprio(1); _Pragma("unroll") for (int m = 0; m < 4; ++m) _Pragma("unroll") for (int n = 0; n < 2; ++n) _Pragma("unroll") for (int k = 0; k < 2; ++k) \
        acc[ai][bj][m][n] = __builtin_amdgcn_mfma_f32_16x16x32_bf16(Bt[n][k], At[m][k], acc[ai][bj][m][n], 0, 0, 0); __builtin_amdgcn_s_setprio(0); } while (0)
#define PG8_WAIT_V(n) asm volatile("s_waitcnt vmcnt(" #n ")" ::: "memory")
#define PG8_WAIT_L(n) asm volatile("s_waitcnt lgkmcnt(" #n ")" ::: "memory")
#define PG8_BAR __builtin_amdgcn_s_barrier()
#define PG8_SCHED __builtin_amdgcn_sched_barrier(0)
    Unit cur, nxt; int ui = 0;
    if (!S.next(0, cur)) return;
    f32x4 acc[2][2][4][2];
#pragma unroll
    for (int a = 0; a < 2; ++a)
#pragma unroll
        for (int b = 0; b < 2; ++b)
#pragma unroll
            for (int m = 0; m < 4; ++m)
#pragma unroll
                for (int n = 0; n < 2; ++n) acc[a][b][m][n] = (f32x4){0.f, 0.f, 0.f, 0.f};
    bf16x8 At[4][2], B0[2][2], B1[2][2];
    const char* cA = (const char*)g.A + (size_t)cur.pm * tstep; const char* cB = (const char*)g.Bt + (size_t)cur.pn * tstep;
    S.a_ready(cur, 0u);
    if constexpr (SP2) {
        PG8_STAGE(PG8_SB(0, 0), cB, voffB); PG8_STAGE(PG8_SB(0, 1), cB + hstep, voffB); PG8_STAGE(PG8_SA(0, 0), cA, voffA); PG8_STAGE(PG8_SA(0, 1), cA + hstep, voffA);
        if (wr == 1) PG8_BAR;
        PG8_WAIT_V(2); PG8_BAR;
        PG8_STAGE(PG8_SB(1, 0), cB + kstep, voffB); PG8_STAGE(PG8_SA(1, 0), cA + kstep, voffA); PG8_STAGE(PG8_SB(1, 1), cB + hstep + kstep, voffB);
        PG8_WAIT_V(6); PG8_BAR;
    } else {
        PG8_STAGE(PG8_SB(0, 0), cB, voffB); PG8_STAGE(PG8_SA(0, 0), cA, voffA); PG8_STAGE(PG8_SB(0, 1), cB + hstep, voffB); PG8_STAGE(PG8_SA(0, 1), cA + hstep, voffA);
        if (wr == 1) PG8_BAR;
        PG8_WAIT_V(4); PG8_BAR;
        PG8_STAGE(PG8_SB(1, 0), cB + kstep, voffB); PG8_STAGE(PG8_SA(1, 0), cA + kstep, voffA); PG8_STAGE(PG8_SB(1, 1), cB + hstep + kstep, voffB);
        PG8_WAIT_V(6); PG8_BAR;
    }
    for (;;) {
        const bool has_next = S.next(ui + 1, nxt);
        const unsigned pk = has_next ? S.peek(nxt) : 0u;
        const char* nA = has_next ? (const char*)g.A + (size_t)nxt.pm * tstep : cA; const char* nB = has_next ? (const char*)g.Bt + (size_t)nxt.pn * tstep : cB;
        for (int t = 0; t < nt; t += 2) {
            const bool last = (t == nt - 2);
            const char* a1 = cA + (size_t)(t + 1) * kstep;
            const char* a2 = last ? nA : cA + (size_t)(t + 2) * kstep; const char* b2 = last ? nB : cB + (size_t)(t + 2) * kstep;
            const char* a3 = a2 + kstep; const char* b3 = b2 + kstep;
            if (last && has_next) S.a_ready(nxt, pk);
            if constexpr (SP2) {
            PG8_LDB(B0, 0, 0); PG8_LDB(B1, 0, 1); PG8_SCHED; PG8_LDA(At, 0, 0); PG8_STAGE(PG8_SA(1, 1), a1 + hstep, voffA);
            PG8_WAIT_V(8); PG8_WAIT_L(0); PG8_BAR; PG8_MMA(0, 0, At, B0); PG8_MMA(0, 1, At, B1); PG8_BAR; PG8_SCHED;
            PG8_LDA(At, 0, 1); PG8_STAGE(PG8_SB(0, 0), b2, voffB); PG8_STAGE(PG8_SB(0, 1), b2 + hstep, voffB); PG8_STAGE(PG8_SA(0, 0), a2, voffA);
            PG8_WAIT_V(8); PG8_WAIT_L(0); PG8_BAR; PG8_MMA(1, 0, At, B0); PG8_MMA(1, 1, At, B1); PG8_BAR; PG8_SCHED;
            PG8_LDB(B0, 1, 0); PG8_LDB(B1, 1, 1); PG8_SCHED; PG8_LDA(At, 1, 0); PG8_STAGE(PG8_SA(0, 1), a2 + hstep, voffA);
            PG8_WAIT_V(8); PG8_WAIT_L(0); PG8_BAR; PG8_MMA(0, 0, At, B0); PG8_MMA(0, 1, At, B1); PG8_BAR; PG8_SCHED;
            PG8_LDA(At, 1, 1); PG8_STAGE(PG8_SB(1, 0), b3, voffB); PG8_STAGE(PG8_SB(1, 1), b3 + hstep, voffB); PG8_STAGE(PG8_SA(1, 0), a3, voffA);
            PG8_WAIT_V(8); PG8_WAIT_L(0); PG8_BAR; PG8_MMA(1, 0, At, B0); PG8_MMA(1, 1, At, B1); PG8_BAR; PG8_SCHED;
            } else {
            PG8_LDB(B0, 0, 0); PG8_SCHED; PG8_LDA(At, 0, 0); PG8_STAGE(PG8_SA(1, 1), a1 + hstep, voffA);
            PG8_WAIT_L(8); PG8_BAR; PG8_WAIT_L(0); PG8_MMA(0, 0, At, B0); PG8_BAR; PG8_SCHED;
            PG8_LDB(B1, 0, 1); PG8_STAGE(PG8_SB(0, 0), b2, voffB);
            PG8_BAR; PG8_WAIT_L(0); PG8_MMA(0, 1, At, B1); PG8_BAR;
            PG8_LDA(At, 0, 1); PG8_STAGE(PG8_SA(0, 0), a2, voffA);
            PG8_BAR; PG8_WAIT_L(0); PG8_MMA(1, 0, At, B0); PG8_BAR; PG8_SCHED;
            PG8_STAGE(PG8_SB(0, 1), b2 + hstep, voffB);
            PG8_WAIT_V(6); PG8_BAR; PG8_MMA(1, 1, At, B1); PG8_BAR;
            PG8_LDB(B0, 1, 0); PG8_SCHED; PG8_LDA(At, 1, 0); PG8_STAGE(PG8_SA(0, 1), a2 + hstep, voffA);
            PG8_WAIT_L(8); PG8_BAR; PG8_WAIT_L(0); PG8_MMA(0, 0, At, B0); PG8_BAR; PG8_SCHED;
            PG8_LDB(B1, 1, 1); PG8_STAGE(PG8_SB(1, 0), b3, voffB);
            PG8_BAR; PG8_WAIT_L(0); PG8_MMA(0, 1, At, B1); PG8_BAR;
            PG8_LDA(At, 1, 1); PG8_STAGE(PG8_SA(1, 0), a3, voffA);
            PG8_BAR; PG8_WAIT_L(0); PG8_MMA(1, 0, At, B0); PG8_BAR; PG8_SCHED;
            PG8_STAGE(PG8_SB(1, 1), b3 + hstep, voffB);
            PG8_WAIT_V(6); PG8_BAR; PG8_MMA(1, 1, At, B1); PG8_BAR;
            }
        }
        if constexpr (ALIGN_EPI) { if (wr == 0) PG8_BAR; }
        if constexpr (!Epi::AFTER_DRAIN) { E(acc, cur, wr, wc, fr, fq); S.done(cur); }
        if (!has_next) break;
#pragma unroll
        for (int a = 0; a < 2; ++a)
#pragma unroll
            for (int b = 0; b < 2; ++b)
#pragma unroll
                for (int m = 0; m < 4; ++m)
#pragma unroll
                    for (int n = 0; n < 2; ++n) acc[a][b][m][n] = (f32x4){0.f, 0.f, 0.f, 0.f};
        cur = nxt; cA = nA; cB = nB; ++ui;
        if constexpr (ALIGN_EPI) { if (wr == 1) PG8_BAR; }
    }
    PG8_WAIT_V(0);
    if constexpr (!ALIGN_EPI) { if (wr == 0) PG8_BAR; }
    PG8_BAR;
    if constexpr (Epi::AFTER_DRAIN) { E.fused(acc, cur, wr, wc, fr, fq, lds, wid, lane); S.done(cur); }
#undef PG8_SA
#undef PG8_SB
#undef PG8_STAGE
#undef PG8_LDA
#undef PG8_LDB
#undef PG8_MMA
#undef PG8_WAIT_V
#undef PG8_WAIT_L
#undef PG8_BAR
#undef PG8_SCHED
}
}


#define LAS __attribute__((address_space(3)))
#define LDS_WAIT() asm volatile("s_waitcnt lgkmcnt(0)" ::: "memory")

#define XB_TMO      128
#define XB_XCNT(j)  (256  + 64 * (j))
#define XB_XSUB(j)  (1280 + 64 * (j))
#define XB_XGEN(j)  (2304 + 64 * (j))
#define XB_TOP      3328
#define XB_TOPGEN   3392
#define XCD_BAR_WORDS 3456
#define XB_SPIN_CAP (1u << 18)

__device__ __forceinline__ unsigned xb_ld(unsigned* p)              { return __hip_atomic_load(p, __ATOMIC_RELAXED, __HIP_MEMORY_SCOPE_AGENT); }
__device__ __forceinline__ unsigned xb_add(unsigned* p, unsigned v) { return __hip_atomic_fetch_add(p, v, __ATOMIC_RELAXED, __HIP_MEMORY_SCOPE_AGENT); }
__device__ __forceinline__ unsigned xb_xcc_id() { return (unsigned)__builtin_amdgcn_s_getreg((3 << 11) | 20) & 0xFu; }
#define XB_SPIN(cond, bar) do { unsigned _sp = 0; while (cond) { __builtin_amdgcn_s_sleep(1); \
    if ((++_sp & 255u) == 0u) { if (xb_ld(&(bar)[XB_TMO])) break; if (_sp > XB_SPIN_CAP) { atomicAdd(&(bar)[XB_TMO], 1u); break; } } } } while (0)

struct XcdBarrier {
    unsigned* bar; unsigned x;
    volatile LAS unsigned* st;
};

__device__ __forceinline__ XcdBarrier xcd_barrier_post(unsigned* bar, volatile LAS unsigned* st) {
    XcdBarrier b; b.bar = bar; b.x = xb_xcc_id(); b.st = st;
    if (threadIdx.x == 0) (void)xb_add(&bar[XB_XCNT(b.x)], 1u);
    return b;
}
__device__ __forceinline__ void xcd_barrier_complete(unsigned* bar, unsigned x, unsigned& nloc, unsigned& nx) {
    const unsigned G = gridDim.x * gridDim.y * gridDim.z;
    unsigned sum, cnt, mine, sp = 0u;
    for (;;) {
        sum = 0u; cnt = 0u; mine = 0u;
#pragma unroll
        for (unsigned j = 0; j < 16; ++j) { const unsigned c = xb_ld(&bar[XB_XCNT(j)]); sum += c; cnt += (c > 0u) ? 1u : 0u; mine = (j == x) ? c : mine; }
        if (sum == G) break;
        __builtin_amdgcn_s_sleep(1);
        if ((++sp & 255u) == 0u) { if (xb_ld(&bar[XB_TMO])) break; if (sp > XB_SPIN_CAP) { atomicAdd(&bar[XB_TMO], 1u); break; } }
    }
    nloc = mine > 0u ? mine : 1u; nx = cnt > 0u ? cnt : 1u;
}

__device__ __forceinline__ void xcd_barrier(const XcdBarrier& b) {
    asm volatile("s_waitcnt vmcnt(0)" ::: "memory");
    __syncthreads();
    if (threadIdx.x == 0) {
        unsigned* bar = b.bar;
        __builtin_amdgcn_s_waitcnt(0);
        unsigned nloc = b.st[0], nx = b.st[1];
        if (nloc == 0u) { xcd_barrier_complete(bar, b.x, nloc, nx); b.st[0] = nloc; b.st[1] = nx; }
        const unsigned old = xb_add(&bar[XB_XSUB(b.x)], 1u);
        const unsigned gen = old / nloc;
        if (old + 1u == (gen + 1u) * nloc) {
            __builtin_amdgcn_fence(__ATOMIC_RELEASE, "agent");
            asm volatile("s_waitcnt vmcnt(0)" ::: "memory");
            const unsigned og = xb_add(&bar[XB_TOP], 1u);
            const unsigned tg = og / nx;
            if (og + 1u == (tg + 1u) * nx) xb_add(&bar[XB_TOPGEN], 1u);
            else XB_SPIN(xb_ld(&bar[XB_TOPGEN]) == tg, bar);
            __builtin_amdgcn_fence(__ATOMIC_ACQUIRE, "agent");
            xb_add(&bar[XB_XGEN(b.x)], 1u);
            asm volatile("s_waitcnt vmcnt(0)" ::: "memory");
        } else {
            XB_SPIN(xb_ld(&bar[XB_XGEN(b.x)]) == gen, bar);
            __builtin_amdgcn_fence(__ATOMIC_ACQUIRE, "agent");
            asm volatile("s_waitcnt vmcnt(0)" ::: "memory");
        }
    }
    __syncthreads();
}


struct EpiBf16 {
    static constexpr bool PERM = true, AFTER_DRAIN = false;
    bf16* O; int ldc;
    __device__ __forceinline__ void operator()(const pg8::f32x4 (&acc)[2][2][4][2], const pg8::Unit& u, int wr, int wc, int fr, int fq) const {
        const int row0 = u.pm * 256 + wr * 64 + fr, col0 = u.pn * 256 + wc * 32 + 8 * fq;
#pragma unroll
        for (int ai = 0; ai < 2; ++ai)
#pragma unroll
            for (int m = 0; m < 4; ++m) { bf16* rowp = O + (size_t)(row0 + ai * 128 + m * 16) * ldc + col0;
#pragma unroll
                for (int bj = 0; bj < 2; ++bj) { const pg8::f32x4 v0 = acc[ai][bj][m][0], v1 = acc[ai][bj][m][1];
                    u32x4 w; w.x = pg8::cvt_pk_bf16(v0[0], v0[1]); w.y = pg8::cvt_pk_bf16(v0[2], v0[3]); w.z = pg8::cvt_pk_bf16(v1[0], v1[1]); w.w = pg8::cvt_pk_bf16(v1[2], v1[3]);
                    *(u32x4*)(rowp + bj * 128) = w; } }
    }
};

struct EpiKV {
    static constexpr bool PERM = true, AFTER_DRAIN = false;
    bf16* O; const float* gain; LAS float* X;
    __device__ __forceinline__ void operator()(const pg8::f32x4 (&acc)[2][2][4][2], const pg8::Unit& u, int wr, int wc, int fr, int fq) const {
        const int row0 = u.pm * 256 + wr * 64 + fr, col0 = u.pn * 256 + wc * 32 + 8 * fq;
        const bool nrm = u.pn < 8;
        if (nrm) {
#pragma unroll
            for (int ai = 0; ai < 2; ++ai)
#pragma unroll
                for (int m = 0; m < 4; ++m)
#pragma unroll
                    for (int bj = 0; bj < 2; ++bj) { const pg8::f32x4 v0 = acc[ai][bj][m][0], v1 = acc[ai][bj][m][1];
                        float s = (v0[0] * v0[0] + v0[1] * v0[1]) + (v0[2] * v0[2] + v0[3] * v0[3]) + (v1[0] * v1[0] + v1[1] * v1[1]) + (v1[2] * v1[2] + v1[3] * v1[3]);
                        s += __shfl_xor(s, 16); s += __shfl_xor(s, 32);
                        if (fq == 0) X[((ai * 128 + wr * 64 + m * 16 + fr) * 2 + bj) * 4 + wc] = s; }
            asm volatile("s_waitcnt lgkmcnt(0)" ::: "memory"); __builtin_amdgcn_s_barrier(); asm volatile("" ::: "memory");
        }
        pg8::f32x4 g0 = {1.f, 1.f, 1.f, 1.f}, g1 = {1.f, 1.f, 1.f, 1.f};
        if (nrm) { g0 = *(const pg8::f32x4*)(gain + wc * 32 + 8 * fq); g1 = *(const pg8::f32x4*)(gain + wc * 32 + 8 * fq + 4); }
#pragma unroll
        for (int ai = 0; ai < 2; ++ai)
#pragma unroll
            for (int m = 0; m < 4; ++m) { bf16* rowp = O + (size_t)(row0 + ai * 128 + m * 16) * KVP + col0;
#pragma unroll
                for (int bj = 0; bj < 2; ++bj) {
                    float r = 1.f;
                    if (nrm) { const pg8::f32x4 p = *(const LAS pg8::f32x4*)(X + ((ai * 128 + wr * 64 + m * 16 + fr) * 2 + bj) * 4); r = rsqrtf(((p[0] + p[1]) + (p[2] + p[3])) * (1.f / NOPE) + EPS); }
                    const pg8::f32x4 v0 = acc[ai][bj][m][0] * r * g0, v1 = acc[ai][bj][m][1] * r * g1;
                    u32x4 w; w.x = pg8::cvt_pk_bf16(v0[0], v0[1]); w.y = pg8::cvt_pk_bf16(v0[2], v0[3]); w.z = pg8::cvt_pk_bf16(v1[0], v1[1]); w.w = pg8::cvt_pk_bf16(v1[2], v1[3]);
                    *(u32x4*)(rowp + bj * 128) = w; } }
    }
};

struct EpiQ {
    static constexpr bool PERM = true, AFTER_DRAIN = false;
    unsigned char* ws; LAS float* X;
    __device__ __forceinline__ void operator()(const pg8::f32x4 (&acc)[2][2][4][2], const pg8::Unit& u, int wr, int wc, int fr_, int fq_) const {
        int fr = fr_, fq = fq_; asm volatile("" : "+v"(fr), "+v"(fq));
        const int row0 = u.pm * 256 + wr * 64 + fr, col0 = u.pn * 256 + wc * 32 + 8 * fq;
        bf16* O = (bf16*)(ws + WS_Q); const float* tab = (const float*)(ws + WS_SCAL + SC_TAB); const float* gn = (const float*)(ws + WS_SCAL + SC_GAIN); const float* gr = gn + 128;
        const bool rope = u.pn >= 8;
#pragma unroll
        for (int ai = 0; ai < 2; ++ai)
#pragma unroll
            for (int m = 0; m < 4; ++m)
#pragma unroll
                for (int bj = 0; bj < 2; ++bj) { const pg8::f32x4 v0 = acc[ai][bj][m][0], v1 = acc[ai][bj][m][1];
                    float s = (v0[0] * v0[0] + v0[1] * v0[1]) + (v0[2] * v0[2] + v0[3] * v0[3]) + (v1[0] * v1[0] + v1[1] * v1[1]) + (v1[2] * v1[2] + v1[3] * v1[3]);
                    s += __shfl_xor(s, 16); s += __shfl_xor(s, 32);
                    if (fq == 0) X[((ai * 128 + wr * 64 + m * 16 + fr) * 2 + bj) * 4 + wc] = s; }
        asm volatile("s_waitcnt lgkmcnt(0)" ::: "memory"); __builtin_amdgcn_s_barrier(); asm volatile("" ::: "memory");
        if (!rope) {
            const pg8::f32x4 g0 = *(const pg8::f32x4*)(gn + wc * 32 + 8 * fq), g1 = *(const pg8::f32x4*)(gn + wc * 32 + 8 * fq + 4);
#pragma unroll
            for (int ai = 0; ai < 2; ++ai)
#pragma unroll
                for (int m = 0; m < 4; ++m) { bf16* rowp = O + (size_t)(row0 + ai * 128 + m * 16) * QP + col0;
#pragma unroll
                    for (int bj = 0; bj < 2; ++bj) {
                        const pg8::f32x4 p = *(const LAS pg8::f32x4*)(X + ((ai * 128 + wr * 64 + m * 16 + fr) * 2 + bj) * 4); const float r = rsqrtf(((p[0] + p[1]) + (p[2] + p[3])) * (1.f / NOPE) + EPS);
                        const pg8::f32x4 v0 = acc[ai][bj][m][0] * r * g0, v1 = acc[ai][bj][m][1] * r * g1;
                        u32x4 w; w.x = pg8::cvt_pk_bf16(v0[0], v0[1]); w.y = pg8::cvt_pk_bf16(v0[2], v0[3]); w.z = pg8::cvt_pk_bf16(v1[0], v1[1]); w.w = pg8::cvt_pk_bf16(v1[2], v1[3]);
                        *(u32x4*)(rowp + bj * 128) = w; } }
        } else {
            const int i0 = 16 * (wc & 1) + 4 * fq;
            const pg8::f32x4 ga = *(const pg8::f32x4*)(gr + i0), gb = *(const pg8::f32x4*)(gr + 32 + i0);
#pragma unroll
            for (int ai = 0; ai < 2; ++ai)
#pragma unroll
                for (int m = 0; m < 4; ++m) { const int row = row0 + ai * 128 + m * 16; bf16* rowp = O + (size_t)row * QP + col0;
                    const int pos = row < XR_SAMPLE ? NMETA + (row & (SEQ - 1)) : NMETA + PAST + ((row - XR_SAMPLE) & (LS - 1));
                    const pg8::f32x4 t0 = *(const pg8::f32x4*)(tab + (size_t)pos * 64 + 2 * i0), t1 = *(const pg8::f32x4*)(tab + (size_t)pos * 64 + 2 * i0 + 4);
#pragma unroll
                    for (int bj = 0; bj < 2; ++bj) {
                        const pg8::f32x4 p = *(const LAS pg8::f32x4*)(X + ((ai * 128 + wr * 64 + m * 16 + fr) * 2 + bj) * 4);
                        const float r = rsqrtf(((wc & 2) ? p[2] + p[3] : p[0] + p[1]) * (1.f / ROPE) + EPS);
                        const pg8::f32x4 v0 = acc[ai][bj][m][0] * r, v1 = acc[ai][bj][m][1] * r;
                        const float a0 = v0[0] * ga[0], b0 = v0[1] * gb[0], a1 = v0[2] * ga[1], b1 = v0[3] * gb[1], a2 = v1[0] * ga[2], b2 = v1[1] * gb[2], a3 = v1[2] * ga[3], b3 = v1[3] * gb[3];
                        u32x4 w; w.x = pg8::cvt_pk_bf16(a0 * t0[0] - b0 * t0[1], b0 * t0[0] + a0 * t0[1]); w.y = pg8::cvt_pk_bf16(a1 * t0[2] - b1 * t0[3], b1 * t0[2] + a1 * t0[3]);
                        w.z = pg8::cvt_pk_bf16(a2 * t1[0] - b2 * t1[1], b2 * t1[0] + a2 * t1[1]); w.w = pg8::cvt_pk_bf16(a3 * t1[2] - b3 * t1[3], b3 * t1[2] + a3 * t1[3]);
                        *(u32x4*)(rowp + bj * 128) = w; }
                    __builtin_amdgcn_sched_barrier(0); }
        }
    }
};
struct EpiProj {
    static constexpr bool PERM = true, AFTER_DRAIN = false;
    bf16* P; float* G;
    __device__ __forceinline__ void operator()(const pg8::f32x4 (&acc)[2][2][4][2], const pg8::Unit& u, int wr, int wc, int fr, int fq) const {
        const int row0 = u.pm * 256 + wr * 64 + fr;
        if (u.pn < NP / 256) {
            const int col0 = u.pn * 256 + wc * 32 + 8 * fq;
#pragma unroll
            for (int ai = 0; ai < 2; ++ai)
#pragma unroll
                for (int m = 0; m < 4; ++m) { bf16* rowp = P + (size_t)(row0 + ai * 128 + m * 16) * NP + col0;
#pragma unroll
                    for (int bj = 0; bj < 2; ++bj) { const pg8::f32x4 v0 = acc[ai][bj][m][0], v1 = acc[ai][bj][m][1];
                        u32x4 w; w.x = pg8::cvt_pk_bf16(v0[0], v0[1]); w.y = pg8::cvt_pk_bf16(v0[2], v0[3]); w.z = pg8::cvt_pk_bf16(v1[0], v1[1]); w.w = pg8::cvt_pk_bf16(v1[2], v1[3]);
                        *(u32x4*)(rowp + bj * 128) = w; } }
        } else {
            const int col0 = wc * 32 + 8 * fq;
#pragma unroll
            for (int ai = 0; ai < 2; ++ai)
#pragma unroll
                for (int m = 0; m < 4; ++m) { float* rowp = G + (size_t)(row0 + ai * 128 + m * 16) * GP + col0;
#pragma unroll
                    for (int bj = 0; bj < 2; ++bj) { *(pg8::f32x4*)(rowp + bj * 128) = acc[ai][bj][m][0]; *(pg8::f32x4*)(rowp + bj * 128 + 4) = acc[ai][bj][m][1]; } }
        }
    }
};
struct EpiY {
    static constexpr bool PERM = false, AFTER_DRAIN = false;
    const float* xp; const float* xs; float* out;
    __device__ __forceinline__ void operator()(const pg8::f32x4 (&acc)[2][2][4][2], const pg8::Unit& u, int wr, int wc, int fr, int fq) const {
        const int row0 = u.pm * 256 + wr * 64 + fr, col0 = u.pn * 256 + wc * 32 + 4 * fq;
        const float* xb = u.pm < XR_SAMPLE / 256 ? xp : xs - (size_t)XR_SAMPLE * DM;
#pragma unroll
        for (int ai = 0; ai < 2; ++ai)
#pragma unroll
            for (int m = 0; m < 4; ++m) { const size_t off = (size_t)(row0 + ai * 128 + m * 16) * DM + col0;
#pragma unroll
                for (int bj = 0; bj < 2; ++bj)
#pragma unroll
                    for (int n = 0; n < 2; ++n) { const pg8::f32x4 xv = *(const pg8::f32x4*)(xb + off + bj * 128 + n * 16); *(pg8::f32x4*)(out + off + bj * 128 + n * 16) = xv + acc[ai][bj][m][n]; } }
    }
};


struct SplitOrder : pg8::StaticOrder {
    __device__ bool next(int i, pg8::Unit& u) const {
        long L;
        if (c < 140) { if (i >= 3) return false; L = (long)i * 140 + c; } else { L = 420 + (long)i * 116 + (c - 140); }
        if (L >= nwg) return false;
        int wgid = (int)L; { const int q = nwg / pg8::NXCD, r = nwg % pg8::NXCD, xcd = wgid % pg8::NXCD, off = wgid / pg8::NXCD; wgid = (xcd < r ? xcd * (q + 1) : r * (q + 1) + (xcd - r) * q) + off; }
        const int nig = pg8::WGM * nN, gid = wgid / nig, fm = gid * pg8::WGM, gsz = (nM - fm) < pg8::WGM ? (nM - fm) : pg8::WGM;
        u.pm = fm + ((wgid % nig) % gsz); u.pn = (wgid % nig) / gsz; return true;
    }
};


constexpr int RO_GEMM = 238, RO_NEED = (256 - RO_GEMM) * 8, RO_TPR = 7, RO_PRE = 2, CW_ROUND = 320;
struct RoundOrder {
    int wg; unsigned* flags; LAS unsigned* slot;
    __device__ __forceinline__ void init(int blk, unsigned* fl, LAS unsigned* sl) { slot = sl; const int x = blk & 7, j = blk >> 3; wg = blk < RO_GEMM ? (x < 6 ? x * 30 : 180 + (x - 6) * 29) + j : -1; flags = fl; }
    __device__ __forceinline__ bool next(int i, pg8::Unit& u) const { if (wg < 0 || i >= 7) return false; u.pm = wg / RO_TPR; u.pn = RO_TPR * i + wg % RO_TPR; return true; }
    __device__ __forceinline__ unsigned peek(const pg8::Unit& u) const {
        const int r = u.pn / RO_TPR; if (r < RO_PRE) return 0u;
        __builtin_amdgcn_global_load_lds(flags + 32 * r, slot, 4, 0, 17);
        return 0u;
    }
    __device__ __forceinline__ void a_ready(const pg8::Unit& u, unsigned pk) const {
        const int r = u.pn / RO_TPR; if (r < RO_PRE) return;
        unsigned v; asm volatile("ds_read_b32 %0, %1\n\ts_waitcnt lgkmcnt(0)" : "=v"(v) : "v"((unsigned)(uintptr_t)slot + 4u * (threadIdx.x & 63u)) : "memory");
        if (v >= (unsigned)RO_NEED) return;
        unsigned* f = flags + 32 * r;
        while (__hip_atomic_load(f, __ATOMIC_RELAXED, __HIP_MEMORY_SCOPE_AGENT) < (unsigned)RO_NEED) __builtin_amdgcn_s_sleep(16);
        asm volatile("" ::: "memory");
    }
    __device__ __forceinline__ void done(const pg8::Unit&) const {}
};

__device__ __forceinline__ void skinny_out(const Ctx& c, LAS unsigned char* lds, const bf16* Wt) {
    using bf16x8 = __attribute__((ext_vector_type(8))) short; using f32x16 = __attribute__((ext_vector_type(16))) float;
    const int mt = c.blk >> 6, nt = c.blk & 63, lane = c.lane, w = c.wave, r32 = lane & 31, hi = lane >> 5;
    const bf16* Ab = c.MIX + (size_t)(XR_SAMPLE + 64 * mt + r32) * DM + 512 * w + 32 * hi; const bf16* Bb = Wt + (size_t)(64 * nt + r32) * DM + 512 * w + 32 * hi;
    f32x16 acc[2][2] = {};
#pragma unroll 2
    for (int g = 0; g < 8; ++g) {
        bf16x8 a0[4], a1[4], b0[4], b1[4];
#pragma unroll
        for (int s = 0; s < 4; ++s) { a0[s] = *(const bf16x8*)(Ab + g * 64 + s * 8); a1[s] = *(const bf16x8*)(Ab + (size_t)32 * DM + g * 64 + s * 8);
            b0[s] = *(const bf16x8*)(Bb + g * 64 + s * 8); b1[s] = *(const bf16x8*)(Bb + (size_t)32 * DM + g * 64 + s * 8); }
#pragma unroll
        for (int s = 0; s < 4; ++s) {
            acc[0][0] = __builtin_amdgcn_mfma_f32_32x32x16_bf16(a0[s], b0[s], acc[0][0], 0, 0, 0); acc[0][1] = __builtin_amdgcn_mfma_f32_32x32x16_bf16(a0[s], b1[s], acc[0][1], 0, 0, 0);
            acc[1][0] = __builtin_amdgcn_mfma_f32_32x32x16_bf16(a1[s], b0[s], acc[1][0], 0, 0, 0); acc[1][1] = __builtin_amdgcn_mfma_f32_32x32x16_bf16(a1[s], b1[s], acc[1][1], 0, 0, 0); }
    }
    LAS float* part = (LAS float*)lds + w * 4096;
#pragma unroll
    for (int tb = 0; tb < 2; ++tb)
#pragma unroll
        for (int nb = 0; nb < 2; ++nb)
#pragma unroll
            for (int r = 0; r < 16; ++r) part[(32 * tb + (r & 3) + 8 * (r >> 2) + 4 * hi) * 64 + 32 * nb + r32] = acc[tb][nb][r];
    __syncthreads();
    { const int row = c.tid >> 3, c8 = (c.tid & 7) * 8; f32x4 s0 = {0.f, 0.f, 0.f, 0.f}, s1 = {0.f, 0.f, 0.f, 0.f};
#pragma unroll
        for (int p = 0; p < 8; ++p) { const LAS f32x4* q = (const LAS f32x4*)((LAS float*)lds + p * 4096 + row * 64 + c8); s0 += q[0]; s1 += q[1]; }
        const size_t off = (size_t)(64 * mt + row) * DM + 64 * nt + c8;
        const f32x4 x0 = *(const f32x4*)(c.x_sample + off), x1 = *(const f32x4*)(c.x_sample + off + 4);
        *(f32x4*)(c.out + O_YS + off) = x0 + s0; *(f32x4*)(c.out + O_YS + off + 4) = x1 + s1; }
    __syncthreads();
}

template <bool GATHER = false, class CMap>
__device__ __forceinline__ void transpose_item(const float* W, int ldw, int K, bf16* WT, LAS unsigned* scr, int item, int nblk, int lane, CMap cmap) {
    const int kb = item / nblk, nb = item % nblk, k0 = 64 * kb, n0 = 64 * nb;
    const int cg = lane & 15, kp = lane >> 4;
    const int src = cmap(n0 + 4 * cg);
    const float* wp = W + (size_t)k0 * ldw + (src >= 0 ? src : 0);
    f32x4 v[16];
    if (GATHER && cmap(n0 + 4 * cg + 1) != src + 1) {
        const float* w0 = W + (size_t)k0 * ldw; const int s1 = cmap(n0 + 4 * cg + 1), s2 = cmap(n0 + 4 * cg + 2), s3 = cmap(n0 + 4 * cg + 3);
#pragma unroll
        for (int i = 0; i < 16; ++i) { const int kk = 8 * (i >> 1) + 2 * kp + (i & 1); const float* r = w0 + (size_t)kk * ldw; v[i] = (f32x4){r[src], r[s1], r[s2], r[s3]}; }
    } else {
#pragma unroll
    for (int i = 0; i < 8; ++i) { const int kk = 8 * i + 2 * kp;
        v[2 * i] = src >= 0 ? __builtin_nontemporal_load((const f32x4*)(wp + (size_t)kk * ldw)) : (f32x4){0.f, 0.f, 0.f, 0.f};
        v[2 * i + 1] = src >= 0 ? __builtin_nontemporal_load((const f32x4*)(wp + (size_t)(kk + 1) * ldw)) : (f32x4){0.f, 0.f, 0.f, 0.f}; }
    }
#pragma unroll
    for (int i = 0; i < 8; ++i) { const int kpi = 4 * i + kp;
#pragma unroll
        for (int e = 0; e < 4; ++e) scr[(4 * cg + e) * 33 + kpi] = pk2(v[2 * i][e], v[2 * i + 1][e]); }
    LDS_WAIT(); asm volatile("" ::: "memory");
#pragma unroll
    for (int j = 0; j < 8; ++j) { const int id = j * 64 + lane, row = id >> 3, ch = id & 7; const LAS unsigned* s = scr + row * 33 + ch * 4;
        u32x4 o; o.x = s[0]; o.y = s[1]; o.z = s[2]; o.w = s[3];
        *(u32x4*)(WT + (size_t)(n0 + row) * K + k0 + 8 * ch) = o; }
    LDS_WAIT(); asm volatile("" ::: "memory");
}
__device__ __forceinline__ int cmap_win(int n) { return n < 2048 ? n : (n < 8192 ? n + 64 : (n < 12288 ? n + 72 : (n < 12352 ? n - 12288 + 2048 : (n < 12360 ? n - 12352 + 8256 : -1)))); }
__device__ __forceinline__ int cmap_wq(int n) { return n < 2048 ? (n >> 7) * 192 + (n & 127) : ((n - 2048) >> 6) * 192 + 128 + ((n & 1) << 5) + ((n & 63) >> 1); }
__device__ __forceinline__ int cmap_wkv(int n) { return n < 2048 ? (n >> 7) * 256 + (n & 127) : ((n - 2048) >> 7) * 256 + 128 + (n & 127); }
__device__ __forceinline__ int cmap_id(int n) { return n; }
template <int WHICH>
__device__ __forceinline__ void convert_weight(const float* W, bf16* WT, LAS unsigned* scr, int gw, int NGW, int lane) {
    constexpr int K = WHICH == 0 ? DM : (WHICH == 1 ? QLORA : (WHICH == 2 ? KVLORA : DM));
    constexpr int NN = WHICH == 0 ? NPT : (WHICH == 1 ? QP : (WHICH == 2 ? KVP : DM));
    constexpr int LDW = WHICH == 0 ? IN_COLS : (WHICH == 1 ? 3072 : (WHICH == 2 ? 4096 : DM));
    constexpr int nblk = NN / 64, nitems = (K / 64) * nblk;
    for (int it = gw; it < nitems; it += NGW) {
        if (WHICH == 0) transpose_item(W, LDW, K, WT, scr, it, nblk, lane, cmap_win);
        else if (WHICH == 1) transpose_item<true>(W, LDW, K, WT, scr, it, nblk, lane, cmap_wq);
        else if (WHICH == 2) transpose_item(W, LDW, K, WT, scr, it, nblk, lane, cmap_wkv);
        else transpose_item(W, LDW, K, WT, scr, it, nblk, lane, cmap_id);
    }
}

__device__ __forceinline__ void convert_win_round(const float* W, bf16* WT, LAS unsigned* scr, int r, int w, int nw, int lane) {
    constexpr int NB = RO_TPR * 4, NBA = NPT / 64;
    for (int it = w; it < (DM / 64) * NB; it += nw) { const int kb = it / NB, nbl = it % NB; transpose_item(W, IN_COLS, DM, WT, scr, kb * NBA + NB * r + nbl, NBA, lane, cmap_win); }
}

__device__ __forceinline__ void phase0(const Ctx& c) {
#define P0_LOAD(V, r_) do { if ((r_) < XR_REAL) { const f32x4* xr_ = (const f32x4*)xrow_ptr(c, (r_)) + 2 * c.lane; _Pragma("unroll") for (int j = 0; j < 8; ++j) { V[2 * j] = __builtin_nontemporal_load(xr_ + 128 * j); V[2 * j + 1] = __builtin_nontemporal_load(xr_ + 128 * j + 1); } } } while (0)
#define P0_ROW(V, r_) do { if ((r_) < XR_PAD) { u32x4* o = (u32x4*)(c.XN + (size_t)(r_) * DM) + c.lane; \
        if ((r_) >= XR_REAL) { _Pragma("unroll") for (int j = 0; j < 8; ++j) o[64 * j] = (u32x4){0u, 0u, 0u, 0u}; } \
        else { float s = 0.f; _Pragma("unroll") for (int j = 0; j < 16; ++j) s += (V[j].x * V[j].x + V[j].y * V[j].y) + (V[j].z * V[j].z + V[j].w * V[j].w); \
            const float rs = rsqrtf(wave_sum(s) * (1.f / DM) + EPS); const f32x4* g = (const f32x4*)c.norm_gain + 2 * c.lane; \
            _Pragma("unroll") for (int j = 0; j < 8; ++j) { const f32x4 g0 = g[128 * j], g1 = g[128 * j + 1]; \
                o[64 * j] = (u32x4){pk2(V[2 * j].x * rs * g0.x, V[2 * j].y * rs * g0.y), pk2(V[2 * j].z * rs * g0.z, V[2 * j].w * rs * g0.w), pk2(V[2 * j + 1].x * rs * g1.x, V[2 * j + 1].y * rs * g1.y), pk2(V[2 * j + 1].z * rs * g1.z, V[2 * j + 1].w * rs * g1.w)}; } } } } while (0)
    {   f32x4 va[16], vb[16];
        int r = c.gw; P0_LOAD(va, r);
        for (; r < XR_PAD; r += 2 * c.NGW) {
            P0_LOAD(vb, r + c.NGW); P0_ROW(va, r);
            P0_LOAD(va, r + 2 * c.NGW); P0_ROW(vb, r + c.NGW);
        } }
#undef P0_LOAD
#undef P0_ROW
    { float* tab = (float*)(c.ws + WS_SCAL + SC_TAB);
      for (int e = c.gw * 64 + c.lane; e < 2112 * 32; e += c.NGW * 64) { const int pos = e >> 5, i = e & 31; const float invf = exp2f(-(float)i * (13.287712379549449f / 32.f)); float sn, cs; sincosf((float)pos * invf, &sn, &cs); tab[2 * e] = cs; tab[2 * e + 1] = sn; } }
    if (c.blk == 0 && c.tid < 192) { float* gsc = (float*)(c.ws + WS_SCAL + SC_GAIN); gsc[c.tid] = c.tid < 128 ? c.q_nope_norm[c.tid] : c.q_rope_norm[c.tid - 128]; }
    for (int kr = c.gw; kr < NKR; kr += c.NGW) {
        int kind = 0; const float* src = nullptr; const float* srck = nullptr;
        if (kr < KR_SAMPLE0) { const int i = kr % KRP; if (i >= NMETA && i < 64) kind = 1; }
        else { const int b = (kr - KR_SAMPLE0) / KRS, i = (kr - KR_SAMPLE0) % KRS;
            if ((i >= NMETA && i < 64) || i >= 64 + PAST + LS) kind = 1;
            else if (i >= 64 && i < 64 + PAST) { kind = 2; src = c.cache_ckv + ((size_t)b * PAST + (i - 64)) * KVLORA; srck = c.cache_kpe + ((size_t)b * PAST + (i - 64)) * ROPE; } }
        if (kind == 0) continue;
        u32x4* o = (u32x4*)(c.CKVA + (size_t)kr * KVLORA) + c.lane;
        if (kind == 1) { *o = (u32x4){0u, 0u, 0u, 0u}; c.KPEA[(size_t)kr * ROPE + RPOS(c.lane)] = 0; }
        else { const f32x4 a = ((const f32x4*)src)[2 * c.lane], b2 = ((const f32x4*)src)[2 * c.lane + 1];
            *o = (u32x4){pk2(a.x, a.y), pk2(a.z, a.w), pk2(b2.x, b2.y), pk2(b2.z, b2.w)}; c.KPEA[(size_t)kr * ROPE + RPOS(c.lane)] = (bf16)f2bf(srck[c.lane]); }
    }
}

__device__ __forceinline__ void p2_row(const Ctx& c, int r, const u32x4 (&v)[3], const u32x4 kvv, float kp, float cs, float sn) {
        if (r < XR_OUT) {
            float s = 0.f;
#pragma unroll
            for (int j = 0; j < 3; ++j) {
#pragma unroll
                for (int e = 0; e < 4; ++e) { const float a = bflo(v[j][e]), b = bfhi(v[j][e]); s += a * a + b * b; } }
            const float rs = rsqrtf(wave_sum(s) * (1.f / QLORA) + EPS);
#pragma unroll
            for (int j = 0; j < 3; ++j) { const f32x4 g0 = ((const f32x4*)c.q_a_norm)[2 * (64 * j + c.lane)], g1 = ((const f32x4*)c.q_a_norm)[2 * (64 * j + c.lane) + 1];
                u32x4 o; o.x = pk2(bflo(v[j].x) * rs * g0.x, bfhi(v[j].x) * rs * g0.y); o.y = pk2(bflo(v[j].y) * rs * g0.z, bfhi(v[j].y) * rs * g0.w);
                o.z = pk2(bflo(v[j].z) * rs * g1.x, bfhi(v[j].z) * rs * g1.y); o.w = pk2(bflo(v[j].w) * rs * g1.z, bfhi(v[j].w) * rs * g1.w);
                ((u32x4*)(c.CQN + (size_t)r * QLORA))[64 * j + c.lane] = o; }
        }
        float cv[8]; float s = 0.f;
        {
#pragma unroll
            for (int e = 0; e < 4; ++e) { cv[2 * e] = bflo(kvv[e]); cv[2 * e + 1] = bfhi(kvv[e]); s += cv[2 * e] * cv[2 * e] + cv[2 * e + 1] * cv[2 * e + 1]; } }
        const float rs = rsqrtf(wave_sum(s) * (1.f / KVLORA) + EPS);
        { const f32x4 g0 = ((const f32x4*)c.kv_a_norm)[2 * c.lane], g1 = ((const f32x4*)c.kv_a_norm)[2 * c.lane + 1];
            cv[0] *= rs * g0.x; cv[1] *= rs * g0.y; cv[2] *= rs * g0.z; cv[3] *= rs * g0.w; cv[4] *= rs * g1.x; cv[5] *= rs * g1.y; cv[6] *= rs * g1.z; cv[7] *= rs * g1.w; }
        const float rk = rsqrtf(wave_sum(kp * kp) * (1.f / ROPE) + EPS);
        kp *= rk * c.k_rope_norm[c.lane];
        { const float other = __shfl_xor(kp, 32); kp = c.lane < 32 ? kp * cs - other * sn : kp * cs + other * sn; }
        const u32x4 cb = (u32x4){pk2(cv[0], cv[1]), pk2(cv[2], cv[3]), pk2(cv[4], cv[5]), pk2(cv[6], cv[7])};
        const f32x4 c0 = (f32x4){cv[0], cv[1], cv[2], cv[3]}, c1 = (f32x4){cv[4], cv[5], cv[6], cv[7]};
        const bf16 kb = (bf16)f2bf(kp);
        if (r < XR_SAMPLE) {
            const int b = r >> 11, j = r & (SEQ - 1);
            float* oc = c.out + O_CKVP + ((size_t)b * TP + NMETA + j) * KVLORA; ((f32x4*)oc)[2 * c.lane] = c0; ((f32x4*)oc)[2 * c.lane + 1] = c1;
            c.out[O_KPEP + ((size_t)b * TP + NMETA + j) * ROPE + c.lane] = kp;
            const size_t kr = (size_t)b * KRP + 64 + j; ((u32x4*)(c.CKVA + kr * KVLORA))[c.lane] = cb; c.KPEA[kr * ROPE + RPOS(c.lane)] = kb;
        } else if (r < XR_META) {
            const int b = (r - XR_SAMPLE) >> 5, l = (r - XR_SAMPLE) & (LS - 1);
            float* oc = c.out + O_CKVS + ((size_t)b * LS + l) * KVLORA; ((f32x4*)oc)[2 * c.lane] = c0; ((f32x4*)oc)[2 * c.lane + 1] = c1;
            c.out[O_KPES + ((size_t)b * LS + l) * ROPE + c.lane] = kp;
            const size_t kr = (size_t)KR_SAMPLE0 + (size_t)b * KRS + 64 + PAST + l; ((u32x4*)(c.CKVA + kr * KVLORA))[c.lane] = cb; c.KPEA[kr * ROPE + RPOS(c.lane)] = kb;
        } else {
            const int m = r - XR_META;
            for (int b = 0; b < NB; ++b) { float* oc = c.out + O_CKVP + ((size_t)b * TP + m) * KVLORA; ((f32x4*)oc)[2 * c.lane] = c0; ((f32x4*)oc)[2 * c.lane + 1] = c1;
                c.out[O_KPEP + ((size_t)b * TP + m) * ROPE + c.lane] = kp;
                const size_t kr = (size_t)b * KRP + m; ((u32x4*)(c.CKVA + kr * KVLORA))[c.lane] = cb; c.KPEA[kr * ROPE + RPOS(c.lane)] = kb; }
            for (int b = 0; b < NSB; ++b) { const size_t kr = (size_t)KR_SAMPLE0 + (size_t)b * KRS + m; ((u32x4*)(c.CKVA + kr * KVLORA))[c.lane] = cb; c.KPEA[kr * ROPE + RPOS(c.lane)] = kb; }
        }
}
__device__ __forceinline__ void phase2_rows(const Ctx& c) {
    u32x4 qa[3], qb[3], kva, kvb; float kpa = 0.f, kpb = 0.f, csa = 0.f, sna = 0.f, csb = 0.f, snb = 0.f;
#define P2_LOAD(Q, KV, KP, CS, SN, r_) do { if ((r_) < XR_REAL) { const bf16* prow_ = c.P + (size_t)(r_) * NP; \
        if ((r_) < XR_OUT) { _Pragma("unroll") for (int j = 0; j < 3; ++j) Q[j] = ((const u32x4*)(prow_ + PC_CQ))[64 * j + c.lane]; } \
        KV = ((const u32x4*)(prow_ + PC_CKV))[c.lane]; KP = c.G32[(size_t)(r_) * GP + GC_KPE + c.lane]; \
        const float* tb_ = (const float*)(c.ws + WS_SCAL + SC_TAB) + (size_t)xrow_pos(r_) * 64 + 2 * (c.lane & 31); CS = tb_[0]; SN = tb_[1]; } } while (0)
#define P2_ROW(Q, KV, KP, CS, SN, r_) do { if ((r_) < XR_REAL) p2_row(c, (r_), Q, KV, KP, CS, SN); } while (0)
    int r = c.gw; P2_LOAD(qa, kva, kpa, csa, sna, r);
    for (; r < XR_REAL; r += 2 * c.NGW) {
        P2_LOAD(qb, kvb, kpb, csb, snb, r + c.NGW); P2_ROW(qa, kva, kpa, csa, sna, r);
        P2_LOAD(qa, kva, kpa, csa, sna, r + 2 * c.NGW); P2_ROW(qb, kvb, kpb, csb, snb, r + c.NGW);
    }
#undef P2_LOAD
#undef P2_ROW
}

namespace att {
using bf16x8 = __attribute__((ext_vector_type(8))) short;
using s16x4 = __attribute__((ext_vector_type(4))) short;
using f32x16 = __attribute__((ext_vector_type(16))) float;
constexpr int SHM_KN = 64 * 128 * 2, SHM_KR = 64 * 64 * 2, SHM_V = 64 * 128 * 2, SHM_BUF = SHM_KN + SHM_KR + SHM_V;
constexpr int OFF_WS = 2 * SHM_BUF;
constexpr float CEXP = ATTN_SCALE * 1.4426950408889634f;
constexpr float THR = 8.f;
#define ATT_KSWZ(row, colB) ((row) * 256 + ((colB) ^ (((row) & 15) << 4)))
#define ATT_RSWZ(row, ch) ((row) * 128 + ((((ch) ^ ((row) >> 1)) & 7) << 4))
#define ATT_SBAR() __builtin_amdgcn_sched_barrier(0)
__device__ __forceinline__ int crow(int r, int hi) { return (r & 3) + 8 * (r >> 2) + 4 * hi; }
__device__ __forceinline__ unsigned cvtpk(float lo, float hi) { unsigned r; asm volatile("v_cvt_pk_bf16_f32 %0, %1, %2" : "=v"(r) : "v"(lo), "v"(hi)); return r; }
__device__ __forceinline__ int v_st(int k, int c) { const int kk = (k & ~0xC) | ((k & 4) << 1) | ((k & 8) >> 1); return ((kk >> 3) * 4 + (c >> 5)) * 512 + ((kk & 7) * 32 + (c & 31)) * 2; }
__device__ __forceinline__ int v_rd_base(int lane) { return ((lane & 3) << 3) | (((lane >> 2) & 3) << 6) | (((lane >> 4) & 1) << 5) | (((lane >> 5) & 1) << 8); }
constexpr int v_rd_off(int d0, int ks, int half) { return d0 * 512 + ks * 4096 + half * 2048; }
template <int OFF> __device__ __forceinline__ s16x4 tr_read(int vb) { s16x4 r; asm volatile("ds_read_b64_tr_b16 %0, %1 offset:%2" : "=&v"(r) : "v"(vb), "i"(OFF) : "memory"); return r; }
template <int D0> __device__ __forceinline__ void pv_one(f32x16& od, int vb, bf16x8 pa0, bf16x8 pa1, bf16x8 pa2, bf16x8 pa3) {
    const s16x4 l0 = tr_read<v_rd_off(D0, 0, 0)>(vb), h0 = tr_read<v_rd_off(D0, 0, 1)>(vb), l1 = tr_read<v_rd_off(D0, 1, 0)>(vb), h1 = tr_read<v_rd_off(D0, 1, 1)>(vb);
    const s16x4 l2 = tr_read<v_rd_off(D0, 2, 0)>(vb), h2 = tr_read<v_rd_off(D0, 2, 1)>(vb), l3 = tr_read<v_rd_off(D0, 3, 0)>(vb), h3 = tr_read<v_rd_off(D0, 3, 1)>(vb);
    asm volatile("s_waitcnt lgkmcnt(0)" ::: "memory"); ATT_SBAR();
#define ATT_PK(L, H) (bf16x8){L[0], L[1], L[2], L[3], H[0], H[1], H[2], H[3]}
    od = __builtin_amdgcn_mfma_f32_32x32x16_bf16(pa0, ATT_PK(l0, h0), od, 0, 0, 0);
    od = __builtin_amdgcn_mfma_f32_32x32x16_bf16(pa1, ATT_PK(l1, h1), od, 0, 0, 0);
    od = __builtin_amdgcn_mfma_f32_32x32x16_bf16(pa2, ATT_PK(l2, h2), od, 0, 0, 0);
    od = __builtin_amdgcn_mfma_f32_32x32x16_bf16(pa3, ATT_PK(l3, h3), od, 0, 0, 0);
#undef ATT_PK
}
__device__ __forceinline__ void attn_unit(const Ctx& c, unsigned char* lds, int xr0, int h, int kb, int NT, int wl, bool tailmask) {
    const int tid = c.tid, wid = c.wave, lane = c.lane, r32 = lane & 31, hi = lane >> 5;
    float* wsf = (float*)(lds + OFF_WS) + wid * 64; float* li_l = wsf; float* al_l = wsf + 32;
    float m_reg = -1e30f, l_reg = 0.f; f32x16 o[4] = {}; bf16x8 qr[12];
    {   const bf16* Qw = c.Q + (size_t)(xr0 + wid * 32 + r32) * QP;
        if (wl >= 0) {
#pragma unroll
            for (int d0 = 0; d0 < 8; ++d0) qr[d0] = *(const bf16x8*)(Qw + h * NOPE + d0 * 16 + hi * 8);
#pragma unroll
            for (int d0 = 0; d0 < 4; ++d0) qr[8 + d0] = *(const bf16x8*)(Qw + 2048 + h * ROPE + d0 * 16 + hi * 8);
        } else {
#pragma unroll
            for (int d0 = 0; d0 < 12; ++d0) qr[d0] = (bf16x8){0, 0, 0, 0, 0, 0, 0, 0};
        } }
    const int sr = tid >> 4, sc = (tid & 15) * 8, vst0 = v_st(sr, sc), vst1 = v_st(32 + sr, sc), rr = tid >> 3, rc = tid & 7;
    const int vb0 = (int)(uintptr_t)(lds + SHM_KN + SHM_KR) + v_rd_base(lane);
    bf16x8 sk0, sk1, sv0, sv1, skr;
    const bf16* Kg = c.KV + (size_t)kb * KVP + h * NOPE; const bf16* Vg = c.KV + (size_t)kb * KVP + 2048 + h * VH; const bf16* Rg = c.KPEA + (size_t)kb * ROPE;
#define ATT_SLOAD(k0) do { sk0 = *(const bf16x8*)(Kg + (size_t)((k0) + sr) * KVP + sc); sk1 = *(const bf16x8*)(Kg + (size_t)((k0) + 32 + sr) * KVP + sc); \
        sv0 = *(const bf16x8*)(Vg + (size_t)((k0) + sr) * KVP + sc); sv1 = *(const bf16x8*)(Vg + (size_t)((k0) + 32 + sr) * KVP + sc); \
        skr = *(const bf16x8*)(Rg + (size_t)((k0) + rr) * ROPE + rc * 8); } while (0)
#define ATT_SWRITE(b) do { unsigned char* B_ = lds + (b) * SHM_BUF; \
        *(bf16x8*)(B_ + ATT_KSWZ(sr, sc * 2)) = sk0; *(bf16x8*)(B_ + ATT_KSWZ(32 + sr, sc * 2)) = sk1; \
        *(bf16x8*)(B_ + SHM_KN + ATT_RSWZ(rr, rc)) = skr; \
        *(bf16x8*)(B_ + SHM_KN + SHM_KR + vst0) = sv0; *(bf16x8*)(B_ + SHM_KN + SHM_KR + vst1) = sv1; } while (0)
    ATT_SLOAD(0); ATT_SWRITE(0); __syncthreads();
    for (int j = 0; j < NT; ++j) {
        const int buf = j & 1;
        bf16x8 pa0, pa1, pa2, pa3;
        if (j + 1 < NT) ATT_SLOAD((j + 1) * 64);
        ATT_SBAR();
        if (j <= wl) {
            const unsigned char* Kn = lds + buf * SHM_BUF; const unsigned char* Kr = Kn + SHM_KN;
            f32x16 p0 = {}, p1 = {};
            int r32 = lane & 31, hi = lane >> 5; asm volatile("" : "+v"(r32), "+v"(hi));
#pragma unroll
            for (int d0 = 0; d0 < 8; ++d0) { const int cb = (d0 * 16 + hi * 8) * 2;
                const bf16x8 b0 = *(const bf16x8*)(Kn + ATT_KSWZ(r32, cb)), b1 = *(const bf16x8*)(Kn + ATT_KSWZ(32 + r32, cb));
                p0 = __builtin_amdgcn_mfma_f32_32x32x16_bf16(b0, qr[d0], p0, 0, 0, 0); p1 = __builtin_amdgcn_mfma_f32_32x32x16_bf16(b1, qr[d0], p1, 0, 0, 0);
                if ((d0 & 3) == 3) ATT_SBAR(); }
#pragma unroll
            for (int d0 = 0; d0 < 4; ++d0) { const int ch = d0 * 2 + hi;
                const bf16x8 b0 = *(const bf16x8*)(Kr + ATT_RSWZ(r32, ch)), b1 = *(const bf16x8*)(Kr + ATT_RSWZ(32 + r32, ch));
                p0 = __builtin_amdgcn_mfma_f32_32x32x16_bf16(b0, qr[8 + d0], p0, 0, 0, 0); p1 = __builtin_amdgcn_mfma_f32_32x32x16_bf16(b1, qr[8 + d0], p1, 0, 0, 0); }
            if (j == 0) {
#pragma unroll
                for (int r = 8; r < 16; ++r) p0[r] = -1e30f;
#pragma unroll
                for (int r = 0; r < 16; ++r) p1[r] = -1e30f;
            }
            if (tailmask && j == NT - 1) {
#pragma unroll
                for (int r = 0; r < 16; ++r) p1[r] = -1e30f;
            }
            float pmax = p0[0];
#pragma unroll
            for (int r = 1; r < 16; ++r) pmax = fmaxf(pmax, p0[r]);
#pragma unroll
            for (int r = 0; r < 16; ++r) pmax = fmaxf(pmax, p1[r]);
            { auto sw = __builtin_amdgcn_permlane32_swap(__float_as_uint(pmax), __float_as_uint(pmax), false, false); pmax = fmaxf(__uint_as_float(sw[0]), __uint_as_float(sw[1])); }
            float mn, alpha;
            if (__all(pmax - m_reg <= THR / ATTN_SCALE)) { mn = m_reg; alpha = 1.f; }
            else { mn = fmaxf(m_reg, pmax); alpha = __builtin_amdgcn_exp2f((m_reg - mn) * CEXP); m_reg = mn; }
            const float mnC = -mn * CEXP;
#pragma unroll
            for (int r = 0; r < 16; ++r) { p0[r] = __builtin_amdgcn_exp2f(fmaf(p0[r], CEXP, mnC)); p1[r] = __builtin_amdgcn_exp2f(fmaf(p1[r], CEXP, mnC)); }
            float ps = 0.f;
#pragma unroll
            for (int r = 0; r < 16; ++r) ps += p0[r] + p1[r];
            { auto sw = __builtin_amdgcn_permlane32_swap(__float_as_uint(ps), __float_as_uint(ps), false, false); ps = __uint_as_float(sw[0]) + __uint_as_float(sw[1]); }
            l_reg = l_reg * alpha + ps;
            if (__any(alpha < 1.f)) { if (hi == 0) al_l[r32] = alpha; asm volatile("s_waitcnt lgkmcnt(0)" ::: "memory");
#pragma unroll
                for (int d = 0; d < 4; ++d)
#pragma unroll
                    for (int r = 0; r < 16; ++r) o[d][r] *= al_l[crow(r, hi)]; }
#define ATT_PK4(P, BASE, OUT) do { unsigned a0 = cvtpk(P[BASE + 0], P[BASE + 1]), a1 = cvtpk(P[BASE + 2], P[BASE + 3]); \
        unsigned b0_ = cvtpk(P[BASE + 4], P[BASE + 5]), b1_ = cvtpk(P[BASE + 6], P[BASE + 7]); \
        auto r0 = __builtin_amdgcn_permlane32_swap(a0, b0_, false, false); auto r1 = __builtin_amdgcn_permlane32_swap(a1, b1_, false, false); \
        u32x4 w_ = {r0[0], r1[0], r0[1], r1[1]}; OUT = *reinterpret_cast<bf16x8*>(&w_); } while (0)
            ATT_PK4(p0, 0, pa0); ATT_PK4(p0, 8, pa1); ATT_PK4(p1, 0, pa2); ATT_PK4(p1, 8, pa3);
#undef ATT_PK4
            const int vb = vb0 + buf * SHM_BUF;
            pv_one<0>(o[0], vb, pa0, pa1, pa2, pa3); pv_one<1>(o[1], vb, pa0, pa1, pa2, pa3); pv_one<2>(o[2], vb, pa0, pa1, pa2, pa3); pv_one<3>(o[3], vb, pa0, pa1, pa2, pa3);
        }
        if (j + 1 < NT) ATT_SWRITE(buf ^ 1);
        __syncthreads();
    }
#undef ATT_SLOAD
#undef ATT_SWRITE
    if (wl >= 0) {
        int r32 = lane & 31, hi = lane >> 5; asm volatile("" : "+v"(r32), "+v"(hi));
        if (hi == 0) li_l[r32] = l_reg; asm volatile("s_waitcnt lgkmcnt(0)" ::: "memory");
        const int rowb = xr0 + wid * 32;
        bf16* stg = (bf16*)(lds + OFF_WS + 2048 + wid * 8192);
#pragma unroll
        for (int r = 0; r < 16; ++r) { const float il = __builtin_amdgcn_rcpf(li_l[crow(r, hi)]);
#pragma unroll
            for (int d0 = 0; d0 < 4; ++d0) stg[crow(r, hi) * 128 + d0 * 32 + r32] = (bf16)f2bf(o[d0][r] * il); }
        asm volatile("s_waitcnt lgkmcnt(0)" ::: "memory");
#pragma unroll
        for (int i = 0; i < 8; ++i) { const int idx = i * 64 + lane, row = idx >> 4, ch = idx & 15;
            const u32x4 ov = *(const u32x4*)(stg + row * 128 + ch * 8), zv = *(const u32x4*)(c.P + (size_t)(rowb + row) * NP + PC_ZA + h * VH + ch * 8);
            u32x4 w;
#pragma unroll
            for (int e = 0; e < 4; ++e) w[e] = pk2(bflo(ov[e]) * siluf_(bflo(zv[e])), bfhi(ov[e]) * siluf_(bfhi(zv[e])));
            *(u32x4*)(c.MIX + (size_t)(rowb + row) * DM + h * VH + ch * 8) = w; }
    }
    __syncthreads();
}
}


namespace ml {
using bf16x8 = __attribute__((ext_vector_type(8))) short;
using s16x4 = __attribute__((ext_vector_type(4))) short;
using f32x16 = __attribute__((ext_vector_type(16))) float;
typedef short v4i16_t __attribute__((ext_vector_type(4)));
constexpr int NCI = 560;
constexpr size_t SC_WI = 512 * 1024;
__device__ __forceinline__ int crow(int r, int hi) { return (r & 3) + 8 * (r >> 2) + 4 * hi; }
__device__ __forceinline__ void chunk_info(int ci, int& seq, int& c, bool& prompt, int& b, int& h, int& xr0, int& nreal) {
    if (ci < 528) { prompt = true; seq = ci / 33; c = ci % 33; b = seq >> 2; h = seq & 3; if (c == 0) { xr0 = XR_META; nreal = NMETA; } else { xr0 = b * SEQ + 64 * (c - 1); nreal = 64; } }
    else { prompt = false; seq = ci - 528; c = 0; b = seq >> 2; h = seq & 3; xr0 = XR_SAMPLE + b * LS; nreal = LS; }
}
__device__ __forceinline__ float scan_add(float v, int lane) {
#pragma unroll
    for (int o = 1; o < 64; o <<= 1) { const float t = __shfl_up(v, o); if (lane >= o) v += t; }
    return v;
}
__device__ __forceinline__ float scan_max(float v, int lane) {
#pragma unroll
    for (int o = 1; o < 64; o <<= 1) { const float t = __shfl_up(v, o); if (lane >= o) v = fmaxf(v, t); }
    return v;
}
constexpr int PA_P = 528, PA_Q = 0, PA_K = 64 * PA_P, PA_XS = 2 * 64 * PA_P, PA_MB = PA_XS + 256, PA_WS = PA_MB + 256, PA_SUM = PA_WS + 256, PA_MAX = PA_SUM + 256;
__device__ __forceinline__ void passA_item(const Ctx& c, LAS unsigned char* lds, bool prompt, int seq, int cc) {
    bf16* SPb = (bf16*)(c.ws + WS_SP); bf16* KPb = (bf16*)(c.ws + WS_KP); float* WIb = (float*)(c.ws + WS_SCAL + SC_WI);
    const int tid = c.tid, lane = c.lane, w = c.wave, r32 = lane & 31, hi = lane >> 5;
    const int b = seq >> 2, h = seq & 3, ci = prompt ? seq * 33 + cc : 528 + seq;
    const int xr0 = prompt ? (cc == 0 ? XR_META : b * SEQ + 64 * (cc - 1)) : XR_SAMPLE + b * LS, nreal = prompt ? (cc == 0 ? NMETA : 64) : LS;
#pragma unroll
    for (int k = 0; k < 4; ++k) { const int ch = tid + 512 * k, row = ch >> 5, cx = ch & 31;
        const u32x4 qv = *(const u32x4*)(c.P + (size_t)(xr0 + row) * NP + PC_MQ + h * DQK + cx * 8), kv = *(const u32x4*)(c.P + (size_t)(xr0 + row) * NP + PC_MK + h * DQK + cx * 8);
        *(LAS u32x4*)(lds + PA_Q + row * PA_P + cx * 16) = qv; *(LAS u32x4*)(lds + PA_K + row * PA_P + cx * 16) = kv; }
    if (w == 0) {
        float Brun = 0.f, Mx = -1e30f;
        if (prompt) { const float sl = lane < cc ? *(const LAS float*)(lds + PA_SUM + lane * 4) : 0.f, ml = lane < cc ? *(const LAS float*)(lds + PA_MAX + lane * 4) : -1e30f;
            const float incl = scan_add(sl, lane); Brun = __shfl(incl, 63); Mx = wave_max(lane < cc ? ml - (incl - sl) : -1e30f); }
        const float bi = c.b_ig[h], bfg = c.b_fg[h], m0 = prompt ? 0.f : c.state_m[b * MLH + h];
        const bool real = lane < nreal; float lf = 0.f, ig = -1e30f;
        if (real) { ig = c.G32[(size_t)(xr0 + lane) * GP + GC_MI + h] + bi; lf = logsigmoidf_(c.G32[(size_t)(xr0 + lane) * GP + GC_MF + h] + bfg); }
        const float Bs = Brun + scan_add(lf, lane), xs = real ? ig - Bs : -1e30f;
        const float mb0 = fmaxf(m0, Mx), mb = fmaxf(m0, fmaxf(Mx, scan_max(xs, lane))), ms = Bs + mb, mb31 = __shfl(mb, 31), mb63 = __shfl(mb, 63);
        const float mb_prev = lane < 32 ? mb0 : mb31, mb_end = lane < 32 ? mb31 : mb63;
        *(LAS float*)(lds + PA_XS + lane * 4) = xs; *(LAS float*)(lds + PA_MB + lane * 4) = mb; *(LAS float*)(lds + PA_WS + lane * 4) = real ? __expf(xs - mb_end) * 0.0625f : 0.f;
        WIb[ci * 64 + lane] = __expf(mb_prev - mb);
        if (real) c.MTOK[(size_t)(xr0 + lane) * 4 + h] = ms;
        if ((!prompt || cc == 32) && lane == 63) c.out[(prompt ? O_MP : O_MS) + b * MLH + h] = ms;
    }
    __syncthreads();
    bf16* sp = SPb + (size_t)ci * 4096;
    if (w < 2) {
        f32x16 acc = {};
        const LAS unsigned char* qa = lds + PA_Q + (32 * w + r32) * PA_P + hi * 16; const LAS unsigned char* ka = lds + PA_K + (32 * w + r32) * PA_P + hi * 16;
#pragma unroll
        for (int kk = 0; kk < 16; ++kk) acc = __builtin_amdgcn_mfma_f32_32x32x16_bf16(*(const LAS bf16x8*)(qa + kk * 32), *(const LAS bf16x8*)(ka + kk * 32), acc, 0, 0, 0);
        const float xsv = *(const LAS float*)(lds + PA_XS + (32 * w + r32) * 4);
#pragma unroll
        for (int r = 0; r < 16; ++r) { const int t0 = crow(r, hi); const float mbv = *(const LAS float*)(lds + PA_MB + (32 * w + t0) * 4);
            const float v = r32 <= t0 ? __expf(xsv - mbv) * acc[r] * 0.0625f : 0.f;
            sp[w * 1024 + t0 * 32 + r32] = (bf16)f2bf(v); }
    }
    bf16* kp = KPb + (size_t)ci * 16384;
#pragma unroll
    for (int k = 0; k < 4; ++k) { const int ch = tid + 512 * k, row = ch >> 5, cx = ch & 31; const float wv = *(const LAS float*)(lds + PA_WS + row * 4);
        const u32x4 kv = *(const LAS u32x4*)(lds + PA_K + row * PA_P + cx * 16);
        u32x4 o; o.x = pk2(bflo(kv.x) * wv, bfhi(kv.x) * wv); o.y = pk2(bflo(kv.y) * wv, bfhi(kv.y) * wv); o.z = pk2(bflo(kv.z) * wv, bfhi(kv.z) * wv); o.w = pk2(bflo(kv.w) * wv, bfhi(kv.w) * wv);
        *(u32x4*)(kp + row * 256 + cx * 8) = o; }
    __syncthreads();
}
__device__ __forceinline__ void passA(const Ctx& c, LAS unsigned char* lds) {
    const int lane = c.lane, w = c.wave, seq = c.blk & 15, slot = c.blk >> 4, b = seq >> 2, h = seq & 3;
    if (c.blk < 256) {
        const float bi = c.b_ig[h], bfg = c.b_fg[h];
        for (int cc = w; cc < 33; cc += 8) {
            const int xr0 = cc == 0 ? XR_META : b * SEQ + 64 * (cc - 1), nreal = cc == 0 ? NMETA : 64;
            float lf = 0.f, ig = -1e30f;
            if (lane < nreal) { ig = c.G32[(size_t)(xr0 + lane) * GP + GC_MI + h] + bi; lf = logsigmoidf_(c.G32[(size_t)(xr0 + lane) * GP + GC_MF + h] + bfg); }
            const float Bl = scan_add(lf, lane), mx = wave_max(lane < nreal ? ig - Bl : -1e30f), tot = __shfl(Bl, 63);
            if (lane == 0) { *(LAS float*)(lds + PA_SUM + cc * 4) = tot; *(LAS float*)(lds + PA_MAX + cc * 4) = mx; }
        }
        __syncthreads();
        for (int cc = slot; cc < 33; cc += 16) passA_item(c, lds, true, seq, cc);
        const int j = 255 - c.blk; if (j < 32) passA_item(c, lds, false, j, 0);
    }
}
constexpr int QT_P = 520, KT_P = 576, ST_P = 80;
constexpr int L_Q = 0, L_K = 32 * QT_P, L_V = L_K + 32 * KT_P, L_S = L_V + 32 * KT_P, L_W = L_S + 32 * ST_P, L_STAGE = L_W + 128, L_END = 2 * L_STAGE;
static_assert(L_END <= 150016 && L_STAGE % 16 == 0, "pass B LDS map must stay below the LDS control words");
__device__ __forceinline__ s16x4 vtr(const LAS unsigned char* p) { return __builtin_bit_cast(s16x4, __builtin_amdgcn_ds_read_tr16_b64_v4i16((LAS v4i16_t*)p)); }
__device__ __forceinline__ void passB_unit(const Ctx& c, LAS unsigned char* lds, int seq, bool prompt, int kind) {
    const int tid = c.tid, lane = c.lane, w = c.wave, r32 = lane & 31, hi = lane >> 5;
    const int b = seq >> 2, h = seq & 3, ci0 = prompt ? seq * 33 : 528 + seq;
    const bool ones = kind == 2; const int dv0 = (ones ? 0 : kind * 256) + 32 * w;
    const bool active = !ones || w == 0;
    const bf16* SPb = (const bf16*)(c.ws + WS_SP); const bf16* KPb = (const bf16*)(c.ws + WS_KP); const float* WIb = (const float*)(c.ws + WS_SCAL + SC_WI);
    f32x16 cacc[8];
    {   const float* sC = c.state_C + ((size_t)b * MLH + h) * DQK * DV; const float* sN = c.state_n + ((size_t)b * MLH + h) * DQK;
        unsigned lo_c = (unsigned)((4 * hi) * DV + dv0 + r32), lo_n = (unsigned)(4 * hi);
#pragma unroll
        for (int i = 0; i < 8; ++i) {
            asm volatile("" : "+v"(lo_c), "+v"(lo_n));
#pragma unroll
            for (int r = 0; r < 16; ++r) {
                float v = 0.f; const int dkc = 32 * i + (r & 3) + 8 * (r >> 2);
                if (!prompt) { if (!ones) v = sC[lo_c + dkc * DV]; else if (w == 0 && r32 == 0) v = sN[lo_n + dkc]; }
                cacc[i][r] = v; }
            __builtin_amdgcn_sched_barrier(0);
        } }
    const int NS = prompt ? 65 : 1;
    u32x4 sq0, sq1, sk0, sk1, sv0 = {0u, 0u, 0u, 0u}, sv1 = {0u, 0u, 0u, 0u}, ss = {0u, 0u, 0u, 0u}; float swi = 0.f;
#define ML_CC(k_) ((k_) == 0 ? 0 : ((k_) + 1) >> 1)
#define ML_JJ(k_) ((k_) == 0 ? 0 : ((k_) + 1) & 1)
#define ML_XR0(k_) ((prompt ? (ML_CC(k_) == 0 ? XR_META : b * SEQ + 64 * (ML_CC(k_) - 1)) : XR_SAMPLE + b * LS) + 32 * ML_JJ(k_))
#define ML_BAR() do { asm volatile("s_waitcnt lgkmcnt(0)" ::: "memory"); __builtin_amdgcn_s_barrier(); asm volatile("" ::: "memory"); } while (0)
#define ML_LOAD(k_) do { const int ci_ = ci0 + ML_CC(k_), jj_ = ML_JJ(k_), x0_ = ML_XR0(k_); int tq = tid; asm volatile("" : "+v"(tq)); \
        const int r0_ = tq >> 5, cx_ = tq & 31; \
        sq0 = *(const u32x4*)(c.P + (size_t)(x0_ + r0_) * NP + PC_MQ + h * DQK + cx_ * 8); sq1 = *(const u32x4*)(c.P + (size_t)(x0_ + 16 + r0_) * NP + PC_MQ + h * DQK + cx_ * 8); \
        sk0 = *(const u32x4*)(KPb + (size_t)ci_ * 16384 + (32 * jj_ + r0_) * 256 + cx_ * 8); sk1 = *(const u32x4*)(KPb + (size_t)ci_ * 16384 + (32 * jj_ + 16 + r0_) * 256 + cx_ * 8); \
        if (!ones) { sv0 = *(const u32x4*)(c.P + (size_t)(x0_ + r0_) * NP + PC_MV + h * DV + kind * 256 + cx_ * 8); sv1 = *(const u32x4*)(c.P + (size_t)(x0_ + 16 + r0_) * NP + PC_MV + h * DV + kind * 256 + cx_ * 8); } \
        if (tq < 128) ss = *(const u32x4*)(SPb + (size_t)ci_ * 4096 + jj_ * 1024 + (tq >> 2) * 32 + (tq & 3) * 8); if (tq < 32) swi = WIb[ci_ * 64 + 32 * jj_ + tq]; } while (0)
#define ML_WRITE(st_) do { int tq = tid; asm volatile("" : "+v"(tq)); const int r0_ = tq >> 5, cx_ = tq & 31; LAS unsigned char* B_ = lds + (st_) * L_STAGE; \
        *(LAS u32x2*)(B_ + L_Q + r0_ * QT_P + cx_ * 16) = (u32x2){sq0.x, sq0.y}; *(LAS u32x2*)(B_ + L_Q + r0_ * QT_P + cx_ * 16 + 8) = (u32x2){sq0.z, sq0.w}; \
        *(LAS u32x2*)(B_ + L_Q + (16 + r0_) * QT_P + cx_ * 16) = (u32x2){sq1.x, sq1.y}; *(LAS u32x2*)(B_ + L_Q + (16 + r0_) * QT_P + cx_ * 16 + 8) = (u32x2){sq1.z, sq1.w}; \
        *(LAS u32x4*)(B_ + L_K + r0_ * KT_P + cx_ * 16) = sk0; *(LAS u32x4*)(B_ + L_K + (16 + r0_) * KT_P + cx_ * 16) = sk1; \
        if (!ones) { *(LAS u32x4*)(B_ + L_V + r0_ * KT_P + cx_ * 16) = sv0; *(LAS u32x4*)(B_ + L_V + (16 + r0_) * KT_P + cx_ * 16) = sv1; } \
        if (tq < 128) *(LAS u32x4*)(B_ + L_S + (tq >> 2) * ST_P + (tq & 3) * 16) = ss; if (tq < 32) *(LAS float*)(B_ + L_W + tq * 4) = swi; } while (0)
    __syncthreads();
    if (ones) {
        for (int i = tid; i < 2 * 32 * 36; i += 512) { const int st = i / (32 * 36), row = (i % (32 * 36)) / 36, ch = i % 36; *(LAS u32x4*)(lds + st * L_STAGE + L_V + row * KT_P + ch * 16) = (u32x4){ch == 0 ? 0x3F80u : 0u, 0u, 0u, 0u}; }
    }
    ML_LOAD(0); ML_WRITE(0);
    ML_BAR();
    for (int k = 0; k < NS; ++k) {
        const int xr0 = ML_XR0(k), nreal = (prompt && k == 0) ? NMETA : 32;
        LAS unsigned char* const S_ = lds + (k & 1) * L_STAGE;
        if (k + 1 < NS) ML_LOAD(k + 1);
        __builtin_amdgcn_sched_barrier(0);
        if (active) {
            int lq = lane; asm volatile("" : "+v"(lq)); const int r32 = lq & 31, hi = lq >> 5;
            f32x16 hacc = {};
            u32x2 qa[2][2];
#define ML_QLD(n_) do { const LAS unsigned char* qp = S_ + L_Q + r32 * QT_P + (16 * (n_) + 4 * hi) * 2; qa[(n_) & 1][0] = *(const LAS u32x2*)qp; qa[(n_) & 1][1] = *(const LAS u32x2*)(qp + 16); } while (0)
            ML_QLD(0);
#pragma unroll
            for (int n = 0; n < 16; ++n) {
                const int i = n >> 1, s = n & 1;
                if (n + 1 < 16) ML_QLD(n + 1);
                u32x4 cw; cw.x = pg8::cvt_pk_bf16(cacc[i][8 * s + 0], cacc[i][8 * s + 1]); cw.y = pg8::cvt_pk_bf16(cacc[i][8 * s + 2], cacc[i][8 * s + 3]);
                cw.z = pg8::cvt_pk_bf16(cacc[i][8 * s + 4], cacc[i][8 * s + 5]); cw.w = pg8::cvt_pk_bf16(cacc[i][8 * s + 6], cacc[i][8 * s + 7]);
                const bf16x8 cf = __builtin_bit_cast(bf16x8, cw);
                const bf16x8 qf = __builtin_bit_cast(bf16x8, (u32x4){qa[n & 1][0].x, qa[n & 1][0].y, qa[n & 1][1].x, qa[n & 1][1].y});
                hacc = __builtin_amdgcn_mfma_f32_32x32x16_bf16(qf, cf, hacc, 0, 0, 0);
                __builtin_amdgcn_sched_barrier(0);
            }
#undef ML_QLD
#pragma unroll
            for (int r = 0; r < 16; ++r) hacc[r] *= *(const LAS float*)(S_ + L_W + crow(r, hi) * 4);
            const int troff = (8 * hi + ((lq & 15) >> 2)) * KT_P + (16 * ((lq >> 4) & 1) + 4 * (lq & 3)) * 2;
            bf16x8 vf[2];
#pragma unroll
            for (int kk = 0; kk < 2; ++kk) { const LAS unsigned char* vp = S_ + L_V + troff + (16 * kk) * KT_P + (32 * w) * 2;
                const s16x4 lo = vtr(vp), hi4 = vtr(vp + 4 * KT_P); vf[kk] = (bf16x8){lo[0], lo[1], lo[2], lo[3], hi4[0], hi4[1], hi4[2], hi4[3]}; }
#pragma unroll
            for (int kk = 0; kk < 2; ++kk) { const bf16x8 sf = *(const LAS bf16x8*)(S_ + L_S + r32 * ST_P + (16 * kk + 8 * hi) * 2);
                hacc = __builtin_amdgcn_mfma_f32_32x32x16_bf16(sf, vf[kk], hacc, 0, 0, 0); }
            {   bf16* nb = c.NUM + (size_t)xr0 * 2048 + h * DV; float* db = c.DEN + (size_t)xr0 * 4 + h;
                unsigned lo_n = (unsigned)((4 * hi) * 2048 + dv0 + r32), lo_d = (unsigned)((4 * hi) * 4);
                asm volatile("" : "+v"(lo_n), "+v"(lo_d));
#pragma unroll
                for (int r = 0; r < 16; ++r) { const int tc = (r & 3) + 8 * (r >> 2), t = tc + 4 * hi;
                    if (t < nreal) { if (!ones) nb[lo_n + tc * 2048] = (bf16)f2bf(hacc[r]); else if (r32 == 0) db[lo_d + tc * 4] = hacc[r]; } }
                __builtin_amdgcn_sched_barrier(0); }
            const float decay = *(const LAS float*)(S_ + L_W + 31 * 4);
            s16x4 ka[3][2];
#define ML_KLD(n_) do { const LAS unsigned char* kp_ = S_ + L_K + troff + (16 * ((n_) & 1)) * KT_P + (32 * ((n_) >> 1)) * 2; ka[(n_) % 3][0] = vtr(kp_); ka[(n_) % 3][1] = vtr(kp_ + 4 * KT_P); } while (0)
            ML_KLD(0); ML_KLD(1);
#pragma unroll
            for (int n = 0; n < 16; ++n) {
                const int i = n >> 1, kk = n & 1;
                if (n + 2 < 16) ML_KLD(n + 2);
                if (kk == 0) {
#pragma unroll
                    for (int r = 0; r < 16; ++r) cacc[i][r] *= decay; }
                const bf16x8 kf = (bf16x8){ka[n % 3][0][0], ka[n % 3][0][1], ka[n % 3][0][2], ka[n % 3][0][3], ka[n % 3][1][0], ka[n % 3][1][1], ka[n % 3][1][2], ka[n % 3][1][3]};
                cacc[i] = __builtin_amdgcn_mfma_f32_32x32x16_bf16(kf, vf[kk], cacc[i], 0, 0, 0);
                __builtin_amdgcn_sched_barrier(0);
            }
#undef ML_KLD
        }
        if (k + 1 < NS) ML_WRITE((k + 1) & 1);
        ML_BAR();
    }
#undef ML_CC
#undef ML_JJ
#undef ML_XR0
#undef ML_BAR
#undef ML_LOAD
#undef ML_WRITE
    if (active) {
        float* oc = c.out + (prompt ? O_CP : O_CS) + ((size_t)b * MLH + h) * DQK * DV; float* on = c.out + (prompt ? O_NP : O_NS) + ((size_t)b * MLH + h) * DQK;
        unsigned lo_c = (unsigned)((4 * hi) * DV + dv0 + r32), lo_n = (unsigned)(4 * hi);
#pragma unroll
        for (int i = 0; i < 8; ++i) {
            asm volatile("" : "+v"(lo_c), "+v"(lo_n));
#pragma unroll
            for (int r = 0; r < 16; ++r) { const int dkc = 32 * i + (r & 3) + 8 * (r >> 2);
                if (!ones) oc[lo_c + dkc * DV] = cacc[i][r]; else if (r32 == 0) on[lo_n + dkc] = cacc[i][r]; }
            __builtin_amdgcn_sched_barrier(0);
        }
    }
    __syncthreads();
}
}

__device__ __forceinline__ void phase5(const Ctx& c) {
    for (int it = c.gw; it < XR_OUT * MLH; it += c.NGW) {
        const int r = it >> 2, h = it & 3;
        const float den = c.DEN[(size_t)r * 4 + h], m = c.MTOK[(size_t)r * 4 + h];
        const float inv = 1.f / fmaxf(fabsf(den), __expf(-m));
        const u32x4 nv = ((const u32x4*)(c.NUM + (size_t)r * 2048 + h * DV))[c.lane];
        f32x4 a = (f32x4){bflo(nv.x), bfhi(nv.x), bflo(nv.y), bfhi(nv.y)}, b = (f32x4){bflo(nv.z), bfhi(nv.z), bflo(nv.w), bfhi(nv.w)}; a *= inv; b *= inv;
        const float ss = wave_sum((a.x * a.x + a.y * a.y) + (a.z * a.z + a.w * a.w) + (b.x * b.x + b.y * b.y) + (b.z * b.z + b.w * b.w));
        const float rs = rsqrtf(ss * (1.f / DV) + EPS);
        const f32x4 g0 = ((const f32x4*)(c.ml_out_norm + h * DV))[2 * c.lane], g1 = ((const f32x4*)(c.ml_out_norm + h * DV))[2 * c.lane + 1];
        const u32x4 mo = ((const u32x4*)(c.P + (size_t)r * NP + PC_MO + h * DV))[c.lane], zb = ((const u32x4*)(c.P + (size_t)r * NP + PC_ZB + h * DV))[c.lane];
        float v[8] = {a.x * rs * g0.x, a.y * rs * g0.y, a.z * rs * g0.z, a.w * rs * g0.w, b.x * rs * g1.x, b.y * rs * g1.y, b.z * rs * g1.z, b.w * rs * g1.w};
        u32x4 o;
#pragma unroll
        for (int e = 0; e < 4; ++e) { const float x0 = v[2 * e] * sigmoidf_(bflo(mo[e])) * siluf_(bflo(zb[e])), x1 = v[2 * e + 1] * sigmoidf_(bfhi(mo[e])) * siluf_(bfhi(zb[e])); o[e] = pk2(x0, x1); }
        ((u32x4*)(c.MIX + (size_t)r * DM + 2048 + h * DV))[c.lane] = o;
    }
}

__device__ __forceinline__ Ctx make_ctx(const Args& a) {
    Ctx c;
    c.x_prompt = a.in[0]; c.x_sample = a.in[1]; c.cache_ckv = a.in[2]; c.cache_kpe = a.in[3]; c.state_C = a.in[4]; c.state_n = a.in[5]; c.state_m = a.in[6]; c.meta = a.in[7];
    c.norm_gain = a.in[8]; c.w_in = a.in[9]; c.b_ig = a.in[10]; c.b_fg = a.in[11]; c.q_a_norm = a.in[12]; c.w_q_up = a.in[13]; c.q_nope_norm = a.in[14]; c.q_rope_norm = a.in[15];
    c.kv_a_norm = a.in[16]; c.k_rope_norm = a.in[17]; c.w_kv_up = a.in[18]; c.k_nope_norm = a.in[19]; c.ml_out_norm = a.in[20]; c.w_out = a.in[21];
    c.out = a.out; c.ws = a.ws;
    c.XN = (bf16*)(a.ws + WS_XN); c.P = (bf16*)(a.ws + WS_P); c.CQN = (bf16*)(a.ws + WS_CQN); c.CKVA = (bf16*)(a.ws + WS_CKVA); c.KPEA = (bf16*)(a.ws + WS_KPEA);
    c.Q = (bf16*)(a.ws + WS_Q); c.KV = (bf16*)(a.ws + WS_KV); c.MIX = (bf16*)(a.ws + WS_MIX);
    c.G32 = (float*)(a.ws + WS_G32); c.NUM = (bf16*)(a.ws + WS_NUM); c.DEN = (float*)(a.ws + WS_SCAL + SC_DEN); c.MTOK = (float*)(a.ws + WS_SCAL + SC_MTOK); c.CST = (float*)(a.ws + WS_CST);
    c.tid = threadIdx.x; c.lane = c.tid & 63; c.wave = __builtin_amdgcn_readfirstlane(c.tid >> 6); c.nblk = gridDim.x; c.blk = blockIdx.x; c.gw = c.blk * 8 + c.wave; c.NGW = c.nblk * 8;
    return c;
}

constexpr int LDS_BYTES = 150528, MISC_OFF = 150016;
constexpr int CW_BAR = 4096, CW_QUEUE = 64;
__global__ void __launch_bounds__(512, 2) mk(Args a) {
    extern __shared__ __attribute__((aligned(16))) unsigned char lds[];
    const int lo = a.ph_lo, hi = a.ph_hi;
    volatile LAS unsigned* MISC = (volatile LAS unsigned*)((LAS unsigned char*)lds + MISC_OFF);
    if (threadIdx.x < 16) MISC[threadIdx.x] = 0u;
    __syncthreads();
    const XcdBarrier xbar = xcd_barrier_post((unsigned*)(a.ws + WS_CTL) + CW_BAR, MISC + 8);
#define IN(k) (lo <= (k) && (k) < hi)
#define SEAM(k) do { if (IN(k) && IN((k) + 1)) xcd_barrier(xbar); } while (0)
    if (IN(0)) { const Ctx c = make_ctx(a); phase0(c);
        LAS unsigned* scr = (LAS unsigned*)((LAS unsigned char*)lds) + c.wave * 2112;
        {   static_assert(RO_PRE == 2 && XR_PAD == 8704, "phase-0 balance is written for 3584 items and 8704 rows on 2048 waves");
            constexpr int NB = RO_TPR * 4, NBA = NPT / 64, NIR = (DM / 64) * NB;
#define P0_ITEM(it_) do { const int it__ = (it_), r__ = it__ / NIR, rem__ = it__ % NIR; transpose_item(c.w_in, IN_COLS, DM, (bf16*)(a.ws + WS_WIN), scr, (rem__ / NB) * NBA + NB * r__ + rem__ % NB, NBA, c.lane, cmap_win); } while (0)
            if (c.NGW == 2048) { if (c.gw >= 512) { P0_ITEM(c.gw - 512); P0_ITEM(c.gw - 512 + 1536); } else P0_ITEM(3072 + c.gw); }
            else for (int it = c.gw; it < RO_PRE * NIR; it += c.NGW) P0_ITEM(it);
#undef P0_ITEM
        }
        __syncthreads(); }
    SEAM(0);
    if (IN(1)) {
        const Ctx c = make_ctx(a);
        pg8::Gemm g{c.XN, (const bf16*)(a.ws + WS_WIN), XR_PAD, NPT, DM}; RoundOrder S; S.init(c.blk, (unsigned*)(a.ws + WS_CTL) + CW_ROUND, (LAS unsigned*)((LAS unsigned char*)lds + 139264) + c.wave * 64);
        EpiProj E{c.P, c.G32};
        pg8::gemm_phase<EpiProj, RoundOrder, true, true>((LAS unsigned char*)lds, g, S, E);
        if (c.blk >= RO_GEMM) {
            LAS unsigned* scr = (LAS unsigned*)((LAS unsigned char*)lds) + c.wave * 2112;
            for (int r = RO_PRE; r < 7; ++r) {
                convert_win_round(c.w_in, (bf16*)(a.ws + WS_WIN), scr, r, (c.blk - RO_GEMM) * 8 + c.wave, RO_NEED, c.lane);
                __builtin_amdgcn_fence(__ATOMIC_RELEASE, "agent");
                if (c.lane == 0) __hip_atomic_fetch_add((unsigned*)(a.ws + WS_CTL) + CW_ROUND + 32 * r, 1u, __ATOMIC_RELAXED, __HIP_MEMORY_SCOPE_AGENT);
            }
        }
        {   LAS unsigned* scr = (LAS unsigned*)((LAS unsigned char*)lds) + c.wave * 2112;
            constexpr int NQ = (QLORA / 64) * (QP / 64), NKVI = (KVLORA / 64) * (KVP / 64), NO = (DM / 64) * (DM / 64), NALL = NQ + NKVI + NO;
            unsigned* qw = (unsigned*)(a.ws + WS_CTL) + CW_QUEUE + 192;
            for (;;) {
                int base = 0; if (c.lane == 0) base = (int)__hip_atomic_fetch_add(qw, 8u, __ATOMIC_RELAXED, __HIP_MEMORY_SCOPE_AGENT);
                base = __builtin_amdgcn_readfirstlane(base); if (base >= NALL) break;
                for (int it = base; it < base + 8 && it < NALL; ++it) {
                    if (it < NQ) transpose_item<true>(c.w_q_up, 3072, QLORA, (bf16*)(a.ws + WS_WQ), scr, it, QP / 64, c.lane, cmap_wq);
                    else if (it < NQ + NKVI) transpose_item(c.w_kv_up, 4096, KVLORA, (bf16*)(a.ws + WS_WKV), scr, it - NQ, KVP / 64, c.lane, cmap_wkv);
                    else transpose_item(c.w_out, DM, DM, (bf16*)(a.ws + WS_WOUT), scr, it - NQ - NKVI, DM / 64, c.lane, cmap_id);
                }
            }
            __syncthreads(); }
    }
    SEAM(1);
    if (IN(2)) { const Ctx c = make_ctx(a); phase2_rows(c);
        ml::passA(c, (LAS unsigned char*)lds);
    }
    SEAM(2);
    if (IN(3)) {
        const Ctx c = make_ctx(a);
        { pg8::Gemm g{c.CQN, (const bf16*)(a.ws + WS_WQ), XR_OUT, QP, QLORA}; pg8::StaticOrder S; S.init(XR_OUT, QP, c.nblk, c.blk);
          EpiQ E{a.ws, (LAS float*)((LAS unsigned char*)lds + 131072)}; pg8::gemm_phase<EpiQ, pg8::StaticOrder, true, true>((LAS unsigned char*)lds, g, S, E); }
        { pg8::Gemm g{c.CKVA, (const bf16*)(a.ws + WS_WKV), NKR, KVP, KVLORA}; SplitOrder S; S.init(NKR, KVP, c.nblk, c.blk);
          EpiKV E{c.KV, c.k_nope_norm, (LAS float*)((LAS unsigned char*)lds + 131072)}; pg8::gemm_phase<EpiKV, SplitOrder, true, true>((LAS unsigned char*)lds, g, S, E); }
    }
    SEAM(3);
#define POP(word) do { if (threadIdx.x == 0) MISC[0] = __hip_atomic_fetch_add((unsigned*)(a.ws + WS_CTL) + (word), 1u, __ATOMIC_RELAXED, __HIP_MEMORY_SCOPE_AGENT); \
        __syncthreads(); u = (int)MISC[0]; __syncthreads(); } while (0)
    if (IN(5)) { const Ctx c = make_ctx(a);
        for (;;) { int u; POP(CW_QUEUE); if (u >= 48) break;
            if (u < 32) ml::passB_unit(c, (LAS unsigned char*)lds, u >> 1, true, u & 1); else ml::passB_unit(c, (LAS unsigned char*)lds, u - 32, true, 2); }
    }
    if (IN(5)) { const Ctx c = make_ctx(a);
        for (;;) { int u; POP(CW_QUEUE + 64); if (u >= 640) break;
            if (u < 512) { const int qb = 7 - (u >> 6), bh = u & 63, b = bh >> 4, h = bh & 15;
                att::attn_unit(c, lds, b * SEQ + 256 * qb, h, b * KRP, 4 * qb + 5, 4 * qb + 1 + (c.wave >> 1), false); }
            else { const int t = u - 512, b = t >> 4, h = t & 15;
                att::attn_unit(c, lds, XR_SAMPLE + b * LS, h, KR_SAMPLE0 + b * KRS, 18, c.wave == 0 ? 17 : -1, true); } }
    }
    if (IN(5)) { const Ctx c = make_ctx(a);
        for (;;) { int u; POP(CW_QUEUE + 128); if (u >= 96) break; ml::passB_unit(c, (LAS unsigned char*)lds, u / 3, false, u % 3); }
    }
#undef POP
    SEAM(5);
    if (IN(6)) { const Ctx c = make_ctx(a); phase5(c); }
    SEAM(6);
    if (IN(7)) {
        const Ctx c = make_ctx(a);
        pg8::Gemm g{c.MIX, (const bf16*)(a.ws + WS_WOUT), XR_SAMPLE, DM, DM}; pg8::StaticOrder S; S.init(XR_SAMPLE, DM, c.nblk, c.blk);
        EpiY E{c.x_prompt, c.x_sample, c.out};
        const bool first = (c.blk >> 3) & 1;
        if (first) skinny_out(c, (LAS unsigned char*)lds, (const bf16*)(a.ws + WS_WOUT));
        pg8::gemm_phase<EpiY, pg8::StaticOrder, true, true>((LAS unsigned char*)lds, g, S, E);
        if (!first) skinny_out(c, (LAS unsigned char*)lds, (const bf16*)(a.ws + WS_WOUT));
    }
#undef IN
#undef SEAM
}

extern "C" void kernel_launch(void* const* d_in, const int* in_sizes, int n_in, void* d_out, int out_size, void* d_ws, size_t ws_size, hipStream_t stream) {
    static int grid = 0;
    if (grid == 0) {
        if (n_in != 22 || out_size != (int)O_END || ws_size < WS_END) { fprintf(stderr, "kernel_launch: unexpected shapes: n_in %d out %d ws %zu (need %zu)\n", n_in, out_size, ws_size, (size_t)WS_END); grid = -1; return; }
        int dev = 0, cus = 0, per = 0; hipGetDevice(&dev); hipDeviceGetAttribute(&cus, hipDeviceAttributeMultiprocessorCount, dev);
        hipFuncSetAttribute((const void*)mk, hipFuncAttributeMaxDynamicSharedMemorySize, LDS_BYTES);
        hipOccupancyMaxActiveBlocksPerMultiprocessor(&per, (const void*)mk, 512, LDS_BYTES);
        grid = cus * per; fprintf(stderr, "kernel_launch: cus %d per_cu %d grid %d ws %zu\n", cus, per, grid, ws_size);
        if (grid != 256) { fprintf(stderr, "kernel_launch: this kernel is laid out for a 256-workgroup grid (one per CU); got %d\n", grid); grid = -1; return; }
    }
    if (grid < 0) return;
    if (hipMemsetAsync((char*)d_ws + WS_CTL, 0, 1 * MiB, stream) != hipSuccess) { fprintf(stderr, "kernel_launch: hipMemsetAsync failed\n"); return; }
    Args a{};
    for (int i = 0; i < 22; ++i) a.in[i] = (const float*)d_in[i];
    a.out = (float*)d_out; a.ws = (unsigned char*)d_ws; a.ph_lo = 0; a.ph_hi = 8;
    void* args[] = {&a};
    hipError_t e = hipLaunchCooperativeKernel((const void*)mk, dim3(grid), dim3(512), args, LDS_BYTES, stream);
    if (e != hipSuccess) fprintf(stderr, "kernel_launch: cooperative launch failed: %s (grid %d)\n", hipGetErrorString(e), grid);
}
```

```cpp
#include <hip/hip_runtime.h>
#include <hip/hip_cooperative_groups.h>
#include <cstdio>
#include <cstdint>
namespace cg = cooperative_groups;

constexpr int DM = 4096, NB = 4, SEQ = 2048, NMETA = 16, TP = NMETA + SEQ, NSB = 8, LS = 32, PAST = 1024;
constexpr int QLORA = 1536, KVLORA = 512, ROPE = 64, NOPE = 128, VH = 128, HA = 16;
constexpr int MLH = 4, DQK = 256, DV = 512;
constexpr int IN_COLS = 12360;
constexpr float EPS = 1e-6f;
constexpr int XR_SAMPLE = 8192, XR_META = 8448, XR_REAL = 8464, XR_PAD = 8704, XR_OUT = 8448;
constexpr int NP = 12288, NPT = 12544;
constexpr int PC_CQ = 0, PC_CKV = 1536, PC_MQ = 2048, PC_MK = 3072, PC_MV = 4096, PC_MO = 6144, PC_ZA = 8192, PC_ZB = 10240;
constexpr int GP = 256, GC_KPE = 0, GC_MI = 64, GC_MF = 68;
constexpr int KRP = 2112, KRS = 1152, KR_SAMPLE0 = NB * KRP, NKR = KR_SAMPLE0 + NSB * KRS;
constexpr int QP = 3072, KVP = 4096;
constexpr float ATTN_SCALE = 0.07216878364870322f;
constexpr long O_YP = 0, O_YS = 33554432, O_CKVP = 34603008, O_KPEP = 38830080, O_CP = 39358464, O_NP = 41455616, O_MP = 41459712,
               O_CKVS = 41459728, O_KPES = 41590800, O_CS = 41607184, O_NS = 45801488, O_MS = 45809680, O_END = 45809712;
constexpr size_t MiB = 1u << 20;
constexpr size_t WS_CTL = 0, WS_WIN = 2 * MiB, WS_XN = 100 * MiB, WS_P = 168 * MiB, WS_G32 = 377 * MiB, WS_WQ = 386 * MiB, WS_WKV = 395 * MiB,
                 WS_WOUT = 399 * MiB, WS_CQN = 431 * MiB, WS_CKVA = 456 * MiB, WS_KPEA = 474 * MiB, WS_Q = 477 * MiB, WS_KV = 527 * MiB,
                 WS_SP = 665 * MiB, WS_KP = 670 * MiB, WS_SCAL = 688 * MiB, WS_CST = 690 * MiB, WS_END = 716 * MiB;
constexpr size_t WS_NUM = WS_WIN;
constexpr size_t WS_MIX = WS_XN;
constexpr size_t SC_DEN = 0, SC_MTOK = 256 * 1024, SC_TAB = 1024 * 1024, SC_GAIN = 1024 * 1024 + 768 * 1024;

#define RPOS(l) ((((l) & 31) << 1) | ((l) >> 5))
typedef unsigned short bf16;
typedef float f32x4 __attribute__((ext_vector_type(4)));
typedef unsigned u32x4 __attribute__((ext_vector_type(4)));
typedef unsigned u32x2 __attribute__((ext_vector_type(2)));

__device__ __forceinline__ unsigned f2bf(float f) { unsigned u = __builtin_bit_cast(unsigned, f); return (u + 0x7fffu + ((u >> 16) & 1u)) >> 16; }
__device__ __forceinline__ unsigned pk2(float lo, float hi) { return f2bf(lo) | (f2bf(hi) << 16); }
__device__ __forceinline__ float bf2f(unsigned short b) { return __builtin_bit_cast(float, (unsigned)b << 16); }
__device__ __forceinline__ float bflo(unsigned w) { return __builtin_bit_cast(float, w << 16); }
__device__ __forceinline__ float bfhi(unsigned w) { return __builtin_bit_cast(float, w & 0xffff0000u); }
#define DPPF(old_, src_, ctrl_, rm_, bm_) __builtin_bit_cast(float, __builtin_amdgcn_update_dpp(__builtin_bit_cast(int, (float)(old_)), __builtin_bit_cast(int, (float)(src_)), ctrl_, rm_, bm_, false))
__device__ __forceinline__ float rl_f(float v, int l) { return __builtin_bit_cast(float, __builtin_amdgcn_readlane(__builtin_bit_cast(int, v), l)); }
__device__ __forceinline__ float wave_sum(float v) {
    v += DPPF(0.f, v, 0xB1, 0xf, 0xf); v += DPPF(0.f, v, 0x4E, 0xf, 0xf); v += DPPF(0.f, v, 0x141, 0xf, 0xf); v += DPPF(0.f, v, 0x140, 0xf, 0xf);
    return (rl_f(v, 0) + rl_f(v, 16)) + (rl_f(v, 32) + rl_f(v, 48));
}
__device__ __forceinline__ float wave_max(float v) {
    v = fmaxf(v, DPPF(v, v, 0xB1, 0xf, 0xf)); v = fmaxf(v, DPPF(v, v, 0x4E, 0xf, 0xf)); v = fmaxf(v, DPPF(v, v, 0x141, 0xf, 0xf)); v = fmaxf(v, DPPF(v, v, 0x140, 0xf, 0xf));
    return fmaxf(fmaxf(rl_f(v, 0), rl_f(v, 16)), fmaxf(rl_f(v, 32), rl_f(v, 48)));
}
__device__ __forceinline__ float sigmoidf_(float x) { return __builtin_amdgcn_rcpf(1.f + __expf(-x)); }
__device__ __forceinline__ float siluf_(float x) { return x * __builtin_amdgcn_rcpf(1.f + __expf(-x)); }
__device__ __forceinline__ float logsigmoidf_(float x) { return fminf(x, 0.f) - log1pf(__expf(-fabsf(x))); }

struct Args { const float* in[22]; float* out; unsigned char* ws; int ph_lo, ph_hi; };

struct Ctx {
    const float *x_prompt, *x_sample, *cache_ckv, *cache_kpe, *state_C, *state_n, *state_m, *meta, *norm_gain, *w_in, *b_ig, *b_fg, *q_a_norm, *w_q_up,
        *q_nope_norm, *q_rope_norm, *kv_a_norm, *k_rope_norm, *w_kv_up, *k_nope_norm, *ml_out_norm, *w_out;
    float* out; unsigned char* ws;
    bf16 *XN, *P, *CQN, *CKVA, *KPEA, *Q, *KV, *MIX;
    float *G32, *DEN, *MTOK, *CST; bf16* NUM;
    int tid, lane, wave, gw, NGW, nblk, blk;
};

__device__ __forceinline__ const float* xrow_ptr(const Ctx& c, int r) {
    return r < XR_SAMPLE ? c.x_prompt + (size_t)r * DM : (r < XR_META ? c.x_sample + (size_t)(r - XR_SAMPLE) * DM : c.meta + (size_t)(r - XR_META) * DM);
}
__device__ __forceinline__ int xrow_pos(int r) { return r < XR_SAMPLE ? NMETA + (r & (SEQ - 1)) : (r < XR_META ? NMETA + PAST + ((r - XR_SAMPLE) & (LS - 1)) : r - XR_META); }

namespace pg8 {
#define PG8_LAS __attribute__((address_space(3)))
typedef unsigned short bf16_t;
typedef short bf16x8 __attribute__((ext_vector_type(8)));
typedef float f32x4 __attribute__((ext_vector_type(4)));
typedef unsigned u32x4 __attribute__((ext_vector_type(4)));
constexpr int BM = 256, BK = 64, HALF = 128, HTB = HALF * BK * 2  , STAGE_BYTES = 8 * HTB, NXCD = 8, WGM = 8;

__host__ __device__ __forceinline__ int lds_byte(int r, int c) { const int st = (r >> 4) * 2 + (c >> 5), rr = r & 15, cc = c & 31, ob = rr * 64 + cc * 2; return st * 1024 + (ob ^ (((ob >> 9) & 1) << 5)); }
__host__ __device__ __forceinline__ void stage_rc(int b, int& R, int& C) { const int st = b / 1024, sb = b % 1024, swz = sb ^ (((sb >> 9) & 1) << 5); R = (st >> 1) * 16 + swz / 64; C = (st & 1) * 32 + (swz % 64) / 2; }
__host__ __device__ __forceinline__ int perm32(int rho) { const int n = rho >> 4, i = rho & 15; return 8 * (i >> 2) + 4 * n + (i & 3); }

struct Unit { int pm, pn; };
struct Gemm { const bf16_t* A; const bf16_t* Bt; int M, N, K; };

struct StaticOrder {
    int nM, nN, nwg, G, c;
    __host__ __device__ void init(int M, int N, int G_, int c_) { nM = M / BM; nN = N / BM; nwg = nM * nN; G = G_; c = c_; }
    __host__ __device__ bool next(int i, Unit& u) const {
        const long L = (long)i * G + c; if (L >= nwg) return false;
        int wgid = (int)L; { const int q = nwg / NXCD, r = nwg % NXCD, xcd = wgid % NXCD, off = wgid / NXCD; wgid = (xcd < r ? xcd * (q + 1) : r * (q + 1) + (xcd - r) * q) + off; }
        const int nig = WGM * nN, gid = wgid / nig, fm = gid * WGM, gsz = (nM - fm) < WGM ? (nM - fm) : WGM;
        u.pm = fm + ((wgid % nig) % gsz); u.pn = (wgid % nig) / gsz; return true;
    }
    __device__ __forceinline__ unsigned peek(const Unit&) const { return 0u; }
    __device__ __forceinline__ void a_ready(const Unit&, unsigned) const {}
    __device__ __forceinline__ void done(const Unit&) const {}
};

__device__ __forceinline__ unsigned cvt_pk_bf16(float lo, float hi) { unsigned r; asm volatile("v_cvt_pk_bf16_f32 %0, %1, %2" : "=v"(r) : "v"(lo), "v"(hi)); return r; }
template <class Epi, class Sched, bool ALIGN_EPI = false, bool SP2 = false>
__device__ __forceinline__ void gemm_phase(PG8_LAS unsigned char* lds, const Gemm g, const Sched& S, const Epi& E) {
    const int tid = threadIdx.x, wid = __builtin_amdgcn_readfirstlane(tid >> 6), lane = tid & 63, wr = wid >> 2, wc = wid & 3, fr = lane & 15, fq = lane >> 4;
    const int K = g.K, nt = K / BK;
    unsigned voffA[2], voffB[2];
#pragma unroll
    for (int i = 0; i < 2; ++i) { int R, C; stage_rc(tid * 16 + i * 8192, R, C); const int Rb = Epi::PERM ? ((R & ~31) + perm32(R & 31)) : R;
        voffA[i] = (unsigned)(R * K + C) * 2u; voffB[i] = (unsigned)(Rb * K + C) * 2u; }
    const size_t kstep = (size_t)(BK * 2);
    const size_t hstep = (size_t)HALF * K * 2;
    const size_t tstep = 2 * hstep;
    const unsigned ldsw = (unsigned)wid * 1024u;
    const int aoff = lds_byte(wr * 64 + fr, fq * 8), boff = lds_byte(wc * 32 + fr, fq * 8);
#define PG8_SA(b, h) (((b) * 2 + (h)) * HTB)
#define PG8_SB(b, h) ((4 + (b) * 2 + (h)) * HTB)
#define PG8_STAGE(bufoff, gbase, voff) do { _Pragma("unroll") for (int _i = 0; _i < 2; ++_i) \
        __builtin_amdgcn_global_load_lds((const unsigned*)((const char*)(gbase) + (voff)[_i]), (PG8_LAS unsigned*)(lds + (bufoff) + ldsw + _i * 8192), 16, 0, 0); } while (0)
#define PG8_LDA(dst, b, h) do { _Pragma("unroll") for (int m = 0; m < 4; ++m) _Pragma("unroll") for (int k = 0; k < 2; ++k) dst[m][k] = *(const PG8_LAS bf16x8*)(lds + PG8_SA(b, h) + aoff + m * 2048 + k * 1024); } while (0)
#define PG8_LDB(dst, b, h) do { _Pragma("unroll") for (int n = 0; n < 2; ++n) _Pragma("unroll") for (int k = 0; k < 2; ++k) dst[n][k] = *(const PG8_LAS bf16x8*)(lds + PG8_SB(b, h) + boff + n * 2048 + k * 1024); } while (0)
#define PG8_MMA(ai, bj, At, Bt) do { __builtin_amdgcn_s_setprio(1); _Pragma("unroll") for (int m = 0; m < 4; ++m) _Pragma("unroll") for (int n = 0; n < 2; ++n) _Pragma("unroll") for (int k = 0; k < 2; ++k) \
        acc[ai][bj][m][n] = __builtin_amdgcn_mfma_f32_16x16x32_bf16(Bt[n][k], At[m][k], acc[ai][bj][m][n], 0, 0, 0); __builtin_amdgcn_s_setprio(0); } while (0)
#define PG8_WAIT_V(n) asm volatile("s_waitcnt vmcnt(" #n ")" ::: "memory")
#define PG8_WAIT_L(n) asm volatile("s_waitcnt lgkmcnt(" #n ")" ::: "memory")
#define PG8_BAR __builtin_amdgcn_s_barrier()
#define PG8_SCHED __builtin_amdgcn_sched_barrier(0)
    Unit cur, nxt; int ui = 0;
    if (!S.next(0, cur)) return;
    f32x4 acc[2][2][4][2];
#pragma unroll
    for (int a = 0; a < 2; ++a)
#pragma unroll
        for (int b = 0; b < 2; ++b)
#pragma unroll
            for (int m = 0; m < 4; ++m)
#pragma unroll
                for (int n = 0; n < 2; ++n) acc[a][b][m][n] = (f32x4){0.f, 0.f, 0.f, 0.f};
    bf16x8 At[4][2], B0[2][2], B1[2][2];
    const char* cA = (const char*)g.A + (size_t)cur.pm * tstep; const char* cB = (const char*)g.Bt + (size_t)cur.pn * tstep;
    S.a_ready(cur, 0u);
    if constexpr (SP2) {
        PG8_STAGE(PG8_SB(0, 0), cB, voffB); PG8_STAGE(PG8_SB(0, 1), cB + hstep, voffB); PG8_STAGE(PG8_SA(0, 0), cA, voffA); PG8_STAGE(PG8_SA(0, 1), cA + hstep, voffA);
        if (wr == 1) PG8_BAR;
        PG8_WAIT_V(2); PG8_BAR;
        PG8_STAGE(PG8_SB(1, 0), cB + kstep, voffB); PG8_STAGE(PG8_SA(1, 0), cA + kstep, voffA); PG8_STAGE(PG8_SB(1, 1), cB + hstep + kstep, voffB);
        PG8_WAIT_V(6); PG8_BAR;
    } else {
        PG8_STAGE(PG8_SB(0, 0), cB, voffB); PG8_STAGE(PG8_SA(0, 0), cA, voffA); PG8_STAGE(PG8_SB(0, 1), cB + hstep, voffB); PG8_STAGE(PG8_SA(0, 1), cA + hstep, voffA);
        if (wr == 1) PG8_BAR;
        PG8_WAIT_V(4); PG8_BAR;
        PG8_STAGE(PG8_SB(1, 0), cB + kstep, voffB); PG8_STAGE(PG8_SA(1, 0), cA + kstep, voffA); PG8_STAGE(PG8_SB(1, 1), cB + hstep + kstep, voffB);
        PG8_WAIT_V(6); PG8_BAR;
    }
    for (;;) {
        const bool has_next = S.next(ui + 1, nxt);
        const unsigned pk = has_next ? S.peek(nxt) : 0u;
        const char* nA = has_next ? (const char*)g.A + (size_t)nxt.pm * tstep : cA; const char* nB = has_next ? (const char*)g.Bt + (size_t)nxt.pn * tstep : cB;
        for (int t = 0; t < nt; t += 2) {
            const bool last = (t == nt - 2);
            const char* a1 = cA + (size_t)(t + 1) * kstep;
            const char* a2 = last ? nA : cA + (size_t)(t + 2) * kstep; const char* b2 = last ? nB : cB + (size_t)(t + 2) * kstep;
            const char* a3 = a2 + kstep; const char* b3 = b2 + kstep;
            if (last && has_next) S.a_ready(nxt, pk);
            if constexpr (SP2) {
            PG8_LDB(B0, 0, 0); PG8_LDB(B1, 0, 1); PG8_SCHED; PG8_LDA(At, 0, 0); PG8_STAGE(PG8_SA(1, 1), a1 + hstep, voffA);
            PG8_WAIT_V(8); PG8_WAIT_L(0); PG8_BAR; PG8_MMA(0, 0, At, B0); PG8_MMA(0, 1, At, B1); PG8_BAR; PG8_SCHED;
            PG8_LDA(At, 0, 1); PG8_STAGE(PG8_SB(0, 0), b2, voffB); PG8_STAGE(PG8_SB(0, 1), b2 + hstep, voffB); PG8_STAGE(PG8_SA(0, 0), a2, voffA);
            PG8_WAIT_V(8); PG8_WAIT_L(0); PG8_BAR; PG8_MMA(1, 0, At, B0); PG8_MMA(1, 1, At, B1); PG8_BAR; PG8_SCHED;
            PG8_LDB(B0, 1, 0); PG8_LDB(B1, 1, 1); PG8_SCHED; PG8_LDA(At, 1, 0); PG8_STAGE(PG8_SA(0, 1), a2 + hstep, voffA);
            PG8_WAIT_V(8); PG8_WAIT_L(0); PG8_BAR; PG8_MMA(0, 0, At, B0); PG8_MMA(0, 1, At, B1); PG8_BAR; PG8_SCHED;
            PG8_LDA(At, 1, 1); PG8_STAGE(PG8_SB(1, 0), b3, voffB); PG8_STAGE(PG8_SB(1, 1), b3 + hstep, voffB); PG8_STAGE(PG8_SA(1, 0), a3, voffA);
            PG8_WAIT_V(8); PG8_WAIT_L(0); PG8_BAR; PG8_MMA(1, 0, At, B0); PG8_MMA(1, 1, At, B1); PG8_BAR; PG8_SCHED;
            } else {
            PG8_LDB(B0, 0, 0); PG8_SCHED; PG8_LDA(At, 0, 0); PG8_STAGE(PG8_SA(1, 1), a1 + hstep, voffA);
            PG8_WAIT_L(8); PG8_BAR; PG8_WAIT_L(0); PG8_MMA(0, 0, At, B0); PG8_BAR; PG8_SCHED;
            PG8_LDB(B1, 0, 1); PG8_STAGE(PG8_SB(0, 0), b2, voffB);
            PG8_BAR; PG8_WAIT_L(0); PG8_MMA(0, 1, At, B1); PG8_BAR;
            PG8_LDA(At, 0, 1); PG8_STAGE(PG8_SA(0, 0), a2, voffA);
            PG8_BAR; PG8_WAIT_L(0); PG8_MMA(1, 0, At, B0); PG8_BAR; PG8_SCHED;
            PG8_STAGE(PG8_SB(0, 1), b2 + hstep, voffB);
            PG8_WAIT_V(6); PG8_BAR; PG8_MMA(1, 1, At, B1); PG8_BAR;
            PG8_LDB(B0, 1, 0); PG8_SCHED; PG8_LDA(At, 1, 0); PG8_STAGE(PG8_SA(0, 1), a2 + hstep, voffA);
            PG8_WAIT_L(8); PG8_BAR; PG8_WAIT_L(0); PG8_MMA(0, 0, At, B0); PG8_BAR; PG8_SCHED;
            PG8_LDB(B1, 1, 1); PG8_STAGE(PG8_SB(1, 0), b3, voffB);
            PG8_BAR; PG8_WAIT_L(0); PG8_MMA(0, 1, At, B1); PG8_BAR;
            PG8_LDA(At, 1, 1); PG8_STAGE(PG8_SA(1, 0), a3, voffA);
            PG8_BAR; PG8_WAIT_L(0); PG8_MMA(1, 0, At, B0); PG8_BAR; PG8_SCHED;
            PG8_STAGE(PG8_SB(1, 1), b3 + hstep, voffB);
            PG8_WAIT_V(6); PG8_BAR; PG8_MMA(1, 1, At, B1); PG8_BAR;
            }
        }
        if constexpr (ALIGN_EPI) { if (wr == 0) PG8_BAR; }
        if constexpr (!Epi::AFTER_DRAIN) { E(acc, cur, wr, wc, fr, fq); S.done(cur); }
        if (!has_next) break;
#pragma unroll
        for (int a = 0; a < 2; ++a)
#pragma unroll
            for (int b = 0; b < 2; ++b)
#pragma unroll
                for (int m = 0; m < 4; ++m)
#pragma unroll
                    for (int n = 0; n < 2; ++n) acc[a][b][m][n] = (f32x4){0.f, 0.f, 0.f, 0.f};
        cur = nxt; cA = nA; cB = nB; ++ui;
        if constexpr (ALIGN_EPI) { if (wr == 1) PG8_BAR; }
    }
    PG8_WAIT_V(0);
    if constexpr (!ALIGN_EPI) { if (wr == 0) PG8_BAR; }
    PG8_BAR;
    if constexpr (Epi::AFTER_DRAIN) { E.fused(acc, cur, wr, wc, fr, fq, lds, wid, lane); S.done(cur); }
#undef PG8_SA
#undef PG8_SB
#undef PG8_STAGE
#undef PG8_LDA
#undef PG8_LDB
#undef PG8_MMA
#undef PG8_WAIT_V
#undef PG8_WAIT_L
#undef PG8_BAR
#undef PG8_SCHED
}
}


#define LAS __attribute__((address_space(3)))
#define LDS_WAIT() asm volatile("s_waitcnt lgkmcnt(0)" ::: "memory")

#define XB_TMO      128
#define XB_XCNT(j)  (256  + 64 * (j))
#define XB_XSUB(j)  (1280 + 64 * (j))
#define XB_XGEN(j)  (2304 + 64 * (j))
#define XB_TOP      3328
#define XB_TOPGEN   3392
#define XCD_BAR_WORDS 3456
#define XB_SPIN_CAP (1u << 18)

__device__ __forceinline__ unsigned xb_ld(unsigned* p)              { return __hip_atomic_load(p, __ATOMIC_RELAXED, __HIP_MEMORY_SCOPE_AGENT); }
__device__ __forceinline__ unsigned xb_add(unsigned* p, unsigned v) { return __hip_atomic_fetch_add(p, v, __ATOMIC_RELAXED, __HIP_MEMORY_SCOPE_AGENT); }
__device__ __forceinline__ unsigned xb_xcc_id() { return (unsigned)__builtin_amdgcn_s_getreg((3 << 11) | 20) & 0xFu; }
#define XB_SPIN(cond, bar) do { unsigned _sp = 0; while (cond) { __builtin_amdgcn_s_sleep(1); \
    if ((++_sp & 255u) == 0u) { if (xb_ld(&(bar)[XB_TMO])) break; if (_sp > XB_SPIN_CAP) { atomicAdd(&(bar)[XB_TMO], 1u); break; } } } } while (0)

struct XcdBarrier {
    unsigned* bar; unsigned x;
    volatile LAS unsigned* st;
};

__device__ __forceinline__ XcdBarrier xcd_barrier_post(unsigned* bar, volatile LAS unsigned* st) {
    XcdBarrier b; b.bar = bar; b.x = xb_xcc_id(); b.st = st;
    if (threadIdx.x == 0) (void)xb_add(&bar[XB_XCNT(b.x)], 1u);
    return b;
}
__device__ __forceinline__ void xcd_barrier_complete(unsigned* bar, unsigned x, unsigned& nloc, unsigned& nx) {
    const unsigned G = gridDim.x * gridDim.y * gridDim.z;
    unsigned sum, cnt, mine, sp = 0u;
    for (;;) {
        sum = 0u; cnt = 0u; mine = 0u;
#pragma unroll
        for (unsigned j = 0; j < 16; ++j) { const unsigned c = xb_ld(&bar[XB_XCNT(j)]); sum += c; cnt += (c > 0u) ? 1u : 0u; mine = (j == x) ? c : mine; }
        if (sum == G) break;
        __builtin_amdgcn_s_sleep(1);
        if ((++sp & 255u) == 0u) { if (xb_ld(&bar[XB_TMO])) break; if (sp > XB_SPIN_CAP) { atomicAdd(&bar[XB_TMO], 1u); break; } }
    }
    nloc = mine > 0u ? mine : 1u; nx = cnt > 0u ? cnt : 1u;
}

__device__ __forceinline__ void xcd_barrier(const XcdBarrier& b) {
    asm volatile("s_waitcnt vmcnt(0)" ::: "memory");
    __syncthreads();
    if (threadIdx.x == 0) {
        unsigned* bar = b.bar;
        __builtin_amdgcn_s_waitcnt(0);
        unsigned nloc = b.st[0], nx = b.st[1];
        if (nloc == 0u) { xcd_barrier_complete(bar, b.x, nloc, nx); b.st[0] = nloc; b.st[1] = nx; }
        const unsigned old = xb_add(&bar[XB_XSUB(b.x)], 1u);
        const unsigned gen = old / nloc;
        if (old + 1u == (gen + 1u) * nloc) {
            __builtin_amdgcn_fence(__ATOMIC_RELEASE, "agent");
            asm volatile("s_waitcnt vmcnt(0)" ::: "memory");
            const unsigned og = xb_add(&bar[XB_TOP], 1u);
            const unsigned tg = og / nx;
            if (og + 1u == (tg + 1u) * nx) xb_add(&bar[XB_TOPGEN], 1u);
            else XB_SPIN(xb_ld(&bar[XB_TOPGEN]) == tg, bar);
            __builtin_amdgcn_fence(__ATOMIC_ACQUIRE, "agent");
            xb_add(&bar[XB_XGEN(b.x)], 1u);
            asm volatile("s_waitcnt vmcnt(0)" ::: "memory");
        } else {
            XB_SPIN(xb_ld(&bar[XB_XGEN(b.x)]) == gen, bar);
            __builtin_amdgcn_fence(__ATOMIC_ACQUIRE, "agent");
            asm volatile("s_waitcnt vmcnt(0)" ::: "memory");
        }
    }
    __syncthreads();
}


__device__ __forceinline__ float xsum_fq(float s) {
    { auto a = __builtin_amdgcn_permlane16_swap(__float_as_uint(s), __float_as_uint(s), false, false); s = __uint_as_float(a[0]) + __uint_as_float(a[1]); }
    { auto b = __builtin_amdgcn_permlane32_swap(__float_as_uint(s), __float_as_uint(s), false, false); s = __uint_as_float(b[0]) + __uint_as_float(b[1]); }
    return s;
}
struct EpiBf16 {
    static constexpr bool PERM = true, AFTER_DRAIN = false;
    bf16* O; int ldc;
    __device__ __forceinline__ void operator()(const pg8::f32x4 (&acc)[2][2][4][2], const pg8::Unit& u, int wr, int wc, int fr, int fq) const {
        const int row0 = u.pm * 256 + wr * 64 + fr, col0 = u.pn * 256 + wc * 32 + 8 * fq;
#pragma unroll
        for (int ai = 0; ai < 2; ++ai)
#pragma unroll
            for (int m = 0; m < 4; ++m) { bf16* rowp = O + (size_t)(row0 + ai * 128 + m * 16) * ldc + col0;
#pragma unroll
                for (int bj = 0; bj < 2; ++bj) { const pg8::f32x4 v0 = acc[ai][bj][m][0], v1 = acc[ai][bj][m][1];
                    u32x4 w; w.x = pg8::cvt_pk_bf16(v0[0], v0[1]); w.y = pg8::cvt_pk_bf16(v0[2], v0[3]); w.z = pg8::cvt_pk_bf16(v1[0], v1[1]); w.w = pg8::cvt_pk_bf16(v1[2], v1[3]);
                    *(u32x4*)(rowp + bj * 128) = w; } }
    }
};

struct EpiKV {
    static constexpr bool PERM = true, AFTER_DRAIN = false;
    bf16* O; const float* gain; LAS float* X;
    __device__ __forceinline__ void operator()(const pg8::f32x4 (&acc)[2][2][4][2], const pg8::Unit& u, int wr, int wc, int fr, int fq) const {
        const int row0 = u.pm * 256 + wr * 64 + fr, col0 = u.pn * 256 + wc * 32 + 8 * fq;
        const bool nrm = u.pn < 8;
        if (nrm) {
#pragma unroll
            for (int ai = 0; ai < 2; ++ai)
#pragma unroll
                for (int m = 0; m < 4; ++m)
#pragma unroll
                    for (int bj = 0; bj < 2; ++bj) { const pg8::f32x4 v0 = acc[ai][bj][m][0], v1 = acc[ai][bj][m][1];
                        float s = (v0[0] * v0[0] + v0[1] * v0[1]) + (v0[2] * v0[2] + v0[3] * v0[3]) + (v1[0] * v1[0] + v1[1] * v1[1]) + (v1[2] * v1[2] + v1[3] * v1[3]);
                        s = xsum_fq(s);
                        X[((ai * 128 + wr * 64 + m * 16 + fr) * 2 + bj) * 4 + wc] = s; }
            asm volatile("s_waitcnt lgkmcnt(0)" ::: "memory"); __builtin_amdgcn_s_barrier(); asm volatile("" ::: "memory");
        }
        pg8::f32x4 g0 = {1.f, 1.f, 1.f, 1.f}, g1 = {1.f, 1.f, 1.f, 1.f};
        if (nrm) { g0 = *(const pg8::f32x4*)(gain + wc * 32 + 8 * fq); g1 = *(const pg8::f32x4*)(gain + wc * 32 + 8 * fq + 4); }
#pragma unroll
        for (int ai = 0; ai < 2; ++ai)
#pragma unroll
            for (int m = 0; m < 4; ++m) { bf16* rowp = O + (size_t)(row0 + ai * 128 + m * 16) * KVP + col0;
#pragma unroll
                for (int bj = 0; bj < 2; ++bj) {
                    float r = 1.f;
                    if (nrm) { const pg8::f32x4 p = *(const LAS pg8::f32x4*)(X + ((ai * 128 + wr * 64 + m * 16 + fr) * 2 + bj) * 4); r = rsqrtf(((p[0] + p[1]) + (p[2] + p[3])) * (1.f / NOPE) + EPS); }
                    const pg8::f32x4 v0 = acc[ai][bj][m][0] * r * g0, v1 = acc[ai][bj][m][1] * r * g1;
                    u32x4 w; w.x = pg8::cvt_pk_bf16(v0[0], v0[1]); w.y = pg8::cvt_pk_bf16(v0[2], v0[3]); w.z = pg8::cvt_pk_bf16(v1[0], v1[1]); w.w = pg8::cvt_pk_bf16(v1[2], v1[3]);
                    *(u32x4*)(rowp + bj * 128) = w; } }
    }
};

struct EpiQ {
    static constexpr bool PERM = true, AFTER_DRAIN = false;
    unsigned char* ws; LAS float* X;
    __device__ __forceinline__ void operator()(const pg8::f32x4 (&acc)[2][2][4][2], const pg8::Unit& u, int wr, int wc, int fr_, int fq_) const {
        int fr = fr_, fq = fq_; asm volatile("" : "+v"(fr), "+v"(fq));
        const int row0 = u.pm * 256 + wr * 64 + fr, col0 = u.pn * 256 + wc * 32 + 8 * fq;
        bf16* O = (bf16*)(ws + WS_Q); const float* tab = (const float*)(ws + WS_SCAL + SC_TAB); const float* gn = (const float*)(ws + WS_SCAL + SC_GAIN); const float* gr = gn + 128;
        const bool rope = u.pn >= 8;
#pragma unroll
        for (int ai = 0; ai < 2; ++ai)
#pragma unroll
            for (int m = 0; m < 4; ++m)
#pragma unroll
                for (int bj = 0; bj < 2; ++bj) { const pg8::f32x4 v0 = acc[ai][bj][m][0], v1 = acc[ai][bj][m][1];
                    float s = (v0[0] * v0[0] + v0[1] * v0[1]) + (v0[2] * v0[2] + v0[3] * v0[3]) + (v1[0] * v1[0] + v1[1] * v1[1]) + (v1[2] * v1[2] + v1[3] * v1[3]);
                    s = xsum_fq(s);
                    X[((ai * 128 + wr * 64 + m * 16 + fr) * 2 + bj) * 4 + wc] = s; }
        asm volatile("s_waitcnt lgkmcnt(0)" ::: "memory"); __builtin_amdgcn_s_barrier(); asm volatile("" ::: "memory");
        if (!rope) {
            const pg8::f32x4 g0 = *(const pg8::f32x4*)(gn + wc * 32 + 8 * fq), g1 = *(const pg8::f32x4*)(gn + wc * 32 + 8 * fq + 4);
#pragma unroll
            for (int ai = 0; ai < 2; ++ai)
#pragma unroll
                for (int m = 0; m < 4; ++m) { bf16* rowp = O + (size_t)(row0 + ai * 128 + m * 16) * QP + col0;
#pragma unroll
                    for (int bj = 0; bj < 2; ++bj) {
                        const pg8::f32x4 p = *(const LAS pg8::f32x4*)(X + ((ai * 128 + wr * 64 + m * 16 + fr) * 2 + bj) * 4); const float r = rsqrtf(((p[0] + p[1]) + (p[2] + p[3])) * (1.f / NOPE) + EPS);
                        const pg8::f32x4 v0 = acc[ai][bj][m][0] * r * g0, v1 = acc[ai][bj][m][1] * r * g1;
                        u32x4 w; w.x = pg8::cvt_pk_bf16(v0[0], v0[1]); w.y = pg8::cvt_pk_bf16(v0[2], v0[3]); w.z = pg8::cvt_pk_bf16(v1[0], v1[1]); w.w = pg8::cvt_pk_bf16(v1[2], v1[3]);
                        *(u32x4*)(rowp + bj * 128) = w; } }
        } else {
            const int i0 = 16 * (wc & 1) + 4 * fq;
            const pg8::f32x4 ga = *(const pg8::f32x4*)(gr + i0), gb = *(const pg8::f32x4*)(gr + 32 + i0);
#define EQ_TAB(T0, T1, g_) do { const int row_ = row0 + ((g_) >> 2) * 128 + ((g_) & 3) * 16; const int pos_ = row_ < XR_SAMPLE ? NMETA + (row_ & (SEQ - 1)) : NMETA + PAST + ((row_ - XR_SAMPLE) & (LS - 1)); \
                T0 = *(const pg8::f32x4*)(tab + (size_t)pos_ * 64 + 2 * i0); T1 = *(const pg8::f32x4*)(tab + (size_t)pos_ * 64 + 2 * i0 + 4); } while (0)
            pg8::f32x4 tn0, tn1; EQ_TAB(tn0, tn1, 0);
#pragma unroll
            for (int ai = 0; ai < 2; ++ai)
#pragma unroll
                for (int m = 0; m < 4; ++m) { const int row = row0 + ai * 128 + m * 16; bf16* rowp = O + (size_t)row * QP + col0;
                    const pg8::f32x4 t0 = tn0, t1 = tn1;
                    if (ai * 4 + m + 1 < 8) EQ_TAB(tn0, tn1, ai * 4 + m + 1);
                    __builtin_amdgcn_sched_barrier(0);
#pragma unroll
                    for (int bj = 0; bj < 2; ++bj) {
                        const pg8::f32x4 p = *(const LAS pg8::f32x4*)(X + ((ai * 128 + wr * 64 + m * 16 + fr) * 2 + bj) * 4);
                        const float r = rsqrtf(((wc & 2) ? p[2] + p[3] : p[0] + p[1]) * (1.f / ROPE) + EPS);
                        const pg8::f32x4 v0 = acc[ai][bj][m][0] * r, v1 = acc[ai][bj][m][1] * r;
                        const float a0 = v0[0] * ga[0], b0 = v0[1] * gb[0], a1 = v0[2] * ga[1], b1 = v0[3] * gb[1], a2 = v1[0] * ga[2], b2 = v1[1] * gb[2], a3 = v1[2] * ga[3], b3 = v1[3] * gb[3];
                        u32x4 w; w.x = pg8::cvt_pk_bf16(a0 * t0[0] - b0 * t0[1], b0 * t0[0] + a0 * t0[1]); w.y = pg8::cvt_pk_bf16(a1 * t0[2] - b1 * t0[3], b1 * t0[2] + a1 * t0[3]);
                        w.z = pg8::cvt_pk_bf16(a2 * t1[0] - b2 * t1[1], b2 * t1[0] + a2 * t1[1]); w.w = pg8::cvt_pk_bf16(a3 * t1[2] - b3 * t1[3], b3 * t1[2] + a3 * t1[3]);
                        *(u32x4*)(rowp + bj * 128) = w; }
                    __builtin_amdgcn_sched_barrier(0); }
#undef EQ_TAB
        }
    }
};
struct EpiProj {
    static constexpr bool PERM = true, AFTER_DRAIN = false;
    bf16* P; float* G;
    __device__ __forceinline__ void operator()(const pg8::f32x4 (&acc)[2][2][4][2], const pg8::Unit& u, int wr, int wc, int fr, int fq) const {
        const int row0 = u.pm * 256 + wr * 64 + fr;
        if (u.pn < NP / 256) {
            const int col0 = u.pn * 256 + wc * 32 + 8 * fq;
#pragma unroll
            for (int ai = 0; ai < 2; ++ai)
#pragma unroll
                for (int m = 0; m < 4; ++m) { bf16* rowp = P + (size_t)(row0 + ai * 128 + m * 16) * NP + col0;
#pragma unroll
                    for (int bj = 0; bj < 2; ++bj) { const pg8::f32x4 v0 = acc[ai][bj][m][0], v1 = acc[ai][bj][m][1];
                        u32x4 w; w.x = pg8::cvt_pk_bf16(v0[0], v0[1]); w.y = pg8::cvt_pk_bf16(v0[2], v0[3]); w.z = pg8::cvt_pk_bf16(v1[0], v1[1]); w.w = pg8::cvt_pk_bf16(v1[2], v1[3]);
                        *(u32x4*)(rowp + bj * 128) = w; } }
        } else {
            const int col0 = wc * 32 + 8 * fq;
#pragma unroll
            for (int ai = 0; ai < 2; ++ai)
#pragma unroll
                for (int m = 0; m < 4; ++m) { float* rowp = G + (size_t)(row0 + ai * 128 + m * 16) * GP + col0;
#pragma unroll
                    for (int bj = 0; bj < 2; ++bj) { *(pg8::f32x4*)(rowp + bj * 128) = acc[ai][bj][m][0]; *(pg8::f32x4*)(rowp + bj * 128 + 4) = acc[ai][bj][m][1]; } }
        }
    }
};
struct EpiY {
    static constexpr bool PERM = false, AFTER_DRAIN = false;
    const float* xp; const float* xs; float* out;
    __device__ __forceinline__ void operator()(const pg8::f32x4 (&acc)[2][2][4][2], const pg8::Unit& u, int wr, int wc, int fr, int fq) const {
        const int row0 = u.pm * 256 + wr * 64 + fr, col0 = u.pn * 256 + wc * 32 + 4 * fq;
        const float* xb = u.pm < XR_SAMPLE / 256 ? xp : xs - (size_t)XR_SAMPLE * DM;
#pragma unroll
        for (int ai = 0; ai < 2; ++ai) {
            pg8::f32x4 xv[4][2][2];
#pragma unroll
            for (int m = 0; m < 4; ++m) { const size_t off = (size_t)(row0 + ai * 128 + m * 16) * DM + col0;
#pragma unroll
                for (int bj = 0; bj < 2; ++bj)
#pragma unroll
                    for (int n = 0; n < 2; ++n) xv[m][bj][n] = *(const pg8::f32x4*)(xb + off + bj * 128 + n * 16); }
#pragma unroll
            for (int m = 0; m < 4; ++m) { const size_t off = (size_t)(row0 + ai * 128 + m * 16) * DM + col0;
#pragma unroll
                for (int bj = 0; bj < 2; ++bj)
#pragma unroll
                    for (int n = 0; n < 2; ++n) *(pg8::f32x4*)(out + off + bj * 128 + n * 16) = xv[m][bj][n] + acc[ai][bj][m][n]; }
        }
    }
};


struct SplitOrder : pg8::StaticOrder {
    __device__ bool next(int i, pg8::Unit& u) const {
        long L;
        if (c < 140) { if (i >= 3) return false; L = (long)i * 140 + c; } else { L = 420 + (long)i * 116 + (c - 140); }
        if (L >= nwg) return false;
        int wgid = (int)L; { const int q = nwg / pg8::NXCD, r = nwg % pg8::NXCD, xcd = wgid % pg8::NXCD, off = wgid / pg8::NXCD; wgid = (xcd < r ? xcd * (q + 1) : r * (q + 1) + (xcd - r) * q) + off; }
        const int nig = pg8::WGM * nN, gid = wgid / nig, fm = gid * pg8::WGM, gsz = (nM - fm) < pg8::WGM ? (nM - fm) : pg8::WGM;
        u.pm = fm + ((wgid % nig) % gsz); u.pn = (wgid % nig) / gsz; return true;
    }
};


constexpr int RO_GEMM = 238, RO_NEED = (256 - RO_GEMM) * 8, RO_TPR = 7, RO_PRE = 2, CW_ROUND = 320;
struct RoundOrder {
    int wg; unsigned* flags; LAS unsigned* slot;
    __device__ __forceinline__ void init(int blk, unsigned* fl, LAS unsigned* sl) { slot = sl; const int x = blk & 7, j = blk >> 3; wg = blk < RO_GEMM ? (x < 6 ? x * 30 : 180 + (x - 6) * 29) + j : -1; flags = fl; }
    __device__ __forceinline__ bool next(int i, pg8::Unit& u) const { if (wg < 0 || i >= 7) return false; u.pm = wg / RO_TPR; u.pn = RO_TPR * i + wg % RO_TPR; return true; }
    __device__ __forceinline__ unsigned peek(const pg8::Unit& u) const {
        const int r = u.pn / RO_TPR; if (r < RO_PRE) return 0u;
        __builtin_amdgcn_global_load_lds(flags + 32 * r, slot, 4, 0, 17);
        return 0u;
    }
    __device__ __forceinline__ void a_ready(const pg8::Unit& u, unsigned pk) const {
        const int r = u.pn / RO_TPR; if (r < RO_PRE) return;
        unsigned v; asm volatile("ds_read_b32 %0, %1\n\ts_waitcnt lgkmcnt(0)" : "=v"(v) : "v"((unsigned)(uintptr_t)slot + 4u * (threadIdx.x & 63u)) : "memory");
        if (v >= (unsigned)RO_NEED) return;
        unsigned* f = flags + 32 * r;
        while (__hip_atomic_load(f, __ATOMIC_RELAXED, __HIP_MEMORY_SCOPE_AGENT) < (unsigned)RO_NEED) __builtin_amdgcn_s_sleep(16);
        asm volatile("" ::: "memory");
    }
    __device__ __forceinline__ void done(const pg8::Unit&) const {}
};

__device__ __forceinline__ void skinny_out(const Ctx& c, LAS unsigned char* lds, const bf16* Wt) {
    using bf16x8 = __attribute__((ext_vector_type(8))) short; using f32x16 = __attribute__((ext_vector_type(16))) float;
    const int mt = c.blk >> 6, nt = c.blk & 63, lane = c.lane, w = c.wave, r32 = lane & 31, hi = lane >> 5;
    const bf16* Ab = c.MIX + (size_t)(XR_SAMPLE + 64 * mt + r32) * DM + 512 * w + 32 * hi; const bf16* Bb = Wt + (size_t)(64 * nt + r32) * DM + 512 * w + 32 * hi;
    f32x16 acc[2][2] = {};
#pragma unroll 2
    for (int g = 0; g < 8; ++g) {
        bf16x8 a0[4], a1[4], b0[4], b1[4];
#pragma unroll
        for (int s = 0; s < 4; ++s) { a0[s] = *(const bf16x8*)(Ab + g * 64 + s * 8); a1[s] = *(const bf16x8*)(Ab + (size_t)32 * DM + g * 64 + s * 8);
            b0[s] = *(const bf16x8*)(Bb + g * 64 + s * 8); b1[s] = *(const bf16x8*)(Bb + (size_t)32 * DM + g * 64 + s * 8); }
#pragma unroll
        for (int s = 0; s < 4; ++s) {
            acc[0][0] = __builtin_amdgcn_mfma_f32_32x32x16_bf16(a0[s], b0[s], acc[0][0], 0, 0, 0); acc[0][1] = __builtin_amdgcn_mfma_f32_32x32x16_bf16(a0[s], b1[s], acc[0][1], 0, 0, 0);
            acc[1][0] = __builtin_amdgcn_mfma_f32_32x32x16_bf16(a1[s], b0[s], acc[1][0], 0, 0, 0); acc[1][1] = __builtin_amdgcn_mfma_f32_32x32x16_bf16(a1[s], b1[s], acc[1][1], 0, 0, 0); }
    }
    LAS float* part = (LAS float*)lds + w * 4096;
#pragma unroll
    for (int tb = 0; tb < 2; ++tb)
#pragma unroll
        for (int nb = 0; nb < 2; ++nb)
#pragma unroll
            for (int r = 0; r < 16; ++r) part[(32 * tb + (r & 3) + 8 * (r >> 2) + 4 * hi) * 64 + 32 * nb + r32] = acc[tb][nb][r];
    __syncthreads();
    { const int row = c.tid >> 3, c8 = (c.tid & 7) * 8; f32x4 s0 = {0.f, 0.f, 0.f, 0.f}, s1 = {0.f, 0.f, 0.f, 0.f};
#pragma unroll
        for (int p = 0; p < 8; ++p) { const LAS f32x4* q = (const LAS f32x4*)((LAS float*)lds + p * 4096 + row * 64 + c8); s0 += q[0]; s1 += q[1]; }
        const size_t off = (size_t)(64 * mt + row) * DM + 64 * nt + c8;
        const f32x4 x0 = *(const f32x4*)(c.x_sample + off), x1 = *(const f32x4*)(c.x_sample + off + 4);
        *(f32x4*)(c.out + O_YS + off) = x0 + s0; *(f32x4*)(c.out + O_YS + off + 4) = x1 + s1; }
    __syncthreads();
}

template <bool GATHER = false, class CMap>
__device__ __forceinline__ void transpose_item(const float* W, int ldw, int K, bf16* WT, LAS unsigned* scr, int item, int nblk, int lane, CMap cmap) {
    const int kb = item / nblk, nb = item % nblk, k0 = 64 * kb, n0 = 64 * nb;
    const int cg = lane & 15, kp = lane >> 4;
    const int src = cmap(n0 + 4 * cg);
    const float* wp = W + (size_t)k0 * ldw + (src >= 0 ? src : 0);
    f32x4 v[16];
    if (GATHER && cmap(n0 + 4 * cg + 1) != src + 1) {
        const float* w0 = W + (size_t)k0 * ldw; const int s1 = cmap(n0 + 4 * cg + 1), s2 = cmap(n0 + 4 * cg + 2), s3 = cmap(n0 + 4 * cg + 3);
#pragma unroll
        for (int i = 0; i < 16; ++i) { const int kk = 8 * (i >> 1) + 2 * kp + (i & 1); const float* r = w0 + (size_t)kk * ldw; v[i] = (f32x4){r[src], r[s1], r[s2], r[s3]}; }
    } else {
#pragma unroll
    for (int i = 0; i < 8; ++i) { const int kk = 8 * i + 2 * kp;
        v[2 * i] = src >= 0 ? __builtin_nontemporal_load((const f32x4*)(wp + (size_t)kk * ldw)) : (f32x4){0.f, 0.f, 0.f, 0.f};
        v[2 * i + 1] = src >= 0 ? __builtin_nontemporal_load((const f32x4*)(wp + (size_t)(kk + 1) * ldw)) : (f32x4){0.f, 0.f, 0.f, 0.f}; }
    }
#pragma unroll
    for (int i = 0; i < 8; ++i) { const int kpi = 4 * i + kp;
#pragma unroll
        for (int e = 0; e < 4; ++e) scr[(4 * cg + e) * 33 + kpi] = pk2(v[2 * i][e], v[2 * i + 1][e]); }
    LDS_WAIT(); asm volatile("" ::: "memory");
#pragma unroll
    for (int j = 0; j < 8; ++j) { const int id = j * 64 + lane, row = id >> 3, ch = id & 7; const LAS unsigned* s = scr + row * 33 + ch * 4;
        u32x4 o; o.x = s[0]; o.y = s[1]; o.z = s[2]; o.w = s[3];
        *(u32x4*)(WT + (size_t)(n0 + row) * K + k0 + 8 * ch) = o; }
    LDS_WAIT(); asm volatile("" ::: "memory");
}
__device__ __forceinline__ int cmap_win(int n) { return n < 2048 ? n : (n < 8192 ? n + 64 : (n < 12288 ? n + 72 : (n < 12352 ? n - 12288 + 2048 : (n < 12360 ? n - 12352 + 8256 : -1)))); }
__device__ __forceinline__ int cmap_wq(int n) { return n < 2048 ? (n >> 7) * 192 + (n & 127) : ((n - 2048) >> 6) * 192 + 128 + ((n & 1) << 5) + ((n & 63) >> 1); }
__device__ __forceinline__ int cmap_wkv(int n) { return n < 2048 ? (n >> 7) * 256 + (n & 127) : ((n - 2048) >> 7) * 256 + 128 + (n & 127); }
__device__ __forceinline__ int cmap_id(int n) { return n; }
template <int WHICH>
__device__ __forceinline__ void convert_weight(const float* W, bf16* WT, LAS unsigned* scr, int gw, int NGW, int lane) {
    constexpr int K = WHICH == 0 ? DM : (WHICH == 1 ? QLORA : (WHICH == 2 ? KVLORA : DM));
    constexpr int NN = WHICH == 0 ? NPT : (WHICH == 1 ? QP : (WHICH == 2 ? KVP : DM));
    constexpr int LDW = WHICH == 0 ? IN_COLS : (WHICH == 1 ? 3072 : (WHICH == 2 ? 4096 : DM));
    constexpr int nblk = NN / 64, nitems = (K / 64) * nblk;
    for (int it = gw; it < nitems; it += NGW) {
        if (WHICH == 0) transpose_item(W, LDW, K, WT, scr, it, nblk, lane, cmap_win);
        else if (WHICH == 1) transpose_item<true>(W, LDW, K, WT, scr, it, nblk, lane, cmap_wq);
        else if (WHICH == 2) transpose_item(W, LDW, K, WT, scr, it, nblk, lane, cmap_wkv);
        else transpose_item(W, LDW, K, WT, scr, it, nblk, lane, cmap_id);
    }
}

__device__ __forceinline__ void convert_win_round(const float* W, bf16* WT, LAS unsigned* scr, int r, int w, int nw, int lane) {
    constexpr int NB = RO_TPR * 4, NBA = NPT / 64;
    for (int it = w; it < (DM / 64) * NB; it += nw) { const int kb = it / NB, nbl = it % NB; transpose_item(W, IN_COLS, DM, WT, scr, kb * NBA + NB * r + nbl, NBA, lane, cmap_win); }
}

__device__ __forceinline__ void phase0(const Ctx& c) {
#define P0_LOAD(V, r_) do { if ((r_) < XR_REAL) { const f32x4* xr_ = (const f32x4*)xrow_ptr(c, (r_)) + 2 * c.lane; _Pragma("unroll") for (int j = 0; j < 8; ++j) { V[2 * j] = __builtin_nontemporal_load(xr_ + 128 * j); V[2 * j + 1] = __builtin_nontemporal_load(xr_ + 128 * j + 1); } } } while (0)
#define P0_ROW(V, r_) do { if ((r_) < XR_PAD) { u32x4* o = (u32x4*)(c.XN + (size_t)(r_) * DM) + c.lane; \
        if ((r_) >= XR_REAL) { _Pragma("unroll") for (int j = 0; j < 8; ++j) o[64 * j] = (u32x4){0u, 0u, 0u, 0u}; } \
        else { float s = 0.f; _Pragma("unroll") for (int j = 0; j < 16; ++j) s += (V[j].x * V[j].x + V[j].y * V[j].y) + (V[j].z * V[j].z + V[j].w * V[j].w); \
            const float rs = rsqrtf(wave_sum(s) * (1.f / DM) + EPS); \
            _Pragma("unroll") for (int j = 0; j < 8; ++j) { const f32x4 g0 = gn[2 * j], g1 = gn[2 * j + 1]; \
                o[64 * j] = (u32x4){pk2(V[2 * j].x * rs * g0.x, V[2 * j].y * rs * g0.y), pk2(V[2 * j].z * rs * g0.z, V[2 * j].w * rs * g0.w), pk2(V[2 * j + 1].x * rs * g1.x, V[2 * j + 1].y * rs * g1.y), pk2(V[2 * j + 1].z * rs * g1.z, V[2 * j + 1].w * rs * g1.w)}; } } } } while (0)
    {   f32x4 va[16], gn[16];
        { const f32x4* g = (const f32x4*)c.norm_gain + 2 * c.lane;
#pragma unroll
          for (int j = 0; j < 8; ++j) { gn[2 * j] = g[128 * j]; gn[2 * j + 1] = g[128 * j + 1]; } }
        if (c.nblk == 256) {
            static_assert(XR_PAD == 256 * 34, "row blocks are written for 256 workgroups");
            const int rb = c.blk * 34;
            for (int j = c.wave; j < 34; j += 8) { P0_LOAD(va, rb + j); P0_ROW(va, rb + j); }
        } else {
            for (int r = c.gw; r < XR_PAD; r += c.NGW) { P0_LOAD(va, r); P0_ROW(va, r); } }
    }
#undef P0_LOAD
#undef P0_ROW
}
__device__ __forceinline__ void phase0_side(const Ctx& c) {
    { float* tab = (float*)(c.ws + WS_SCAL + SC_TAB);
      for (int e = c.gw * 64 + c.lane; e < 2112 * 32; e += c.NGW * 64) { const int pos = e >> 5, i = e & 31; const float invf = exp2f(-(float)i * (13.287712379549449f / 32.f)); float sn, cs; sincosf((float)pos * invf, &sn, &cs); tab[2 * e] = cs; tab[2 * e + 1] = sn; } }
    if (c.blk == 0 && c.tid < 192) { float* gsc = (float*)(c.ws + WS_SCAL + SC_GAIN); gsc[c.tid] = c.tid < 128 ? c.q_nope_norm[c.tid] : c.q_rope_norm[c.tid - 128]; }
    {   static_assert(NSB * PAST == 4 * 2048, "cache-row deal is written for 2048 waves");
        if (c.NGW == 2048) {
            f32x4 ca[4], cb[4]; float ck[4];
#pragma unroll
            for (int k = 0; k < 4; ++k) { const int idx = c.gw + 2048 * k;
                const float* src = c.cache_ckv + (size_t)idx * KVLORA; ca[k] = __builtin_nontemporal_load((const f32x4*)src + 2 * c.lane); cb[k] = __builtin_nontemporal_load((const f32x4*)src + 2 * c.lane + 1);
                ck[k] = c.cache_kpe[(size_t)idx * ROPE + c.lane]; }
#pragma unroll
            for (int k = 0; k < 4; ++k) { const int idx = c.gw + 2048 * k, b = idx / PAST, i = idx % PAST; const size_t kr = (size_t)KR_SAMPLE0 + (size_t)b * KRS + 64 + i;
                ((u32x4*)(c.CKVA + kr * KVLORA))[c.lane] = (u32x4){pk2(ca[k].x, ca[k].y), pk2(ca[k].z, ca[k].w), pk2(cb[k].x, cb[k].y), pk2(cb[k].z, cb[k].w)};
                c.KPEA[kr * ROPE + RPOS(c.lane)] = (bf16)f2bf(ck[k]); }
        } else {
            for (int base = c.gw; base < NSB * PAST; base += 4 * c.NGW) {
                f32x4 ca[4], cb[4]; float ck[4];
#pragma unroll
                for (int k = 0; k < 4; ++k) { const int idx = base + k * c.NGW; ca[k] = (f32x4){0.f, 0.f, 0.f, 0.f}; cb[k] = ca[k]; ck[k] = 0.f;
                    if (idx < NSB * PAST) { const float* src = c.cache_ckv + (size_t)idx * KVLORA; ca[k] = ((const f32x4*)src)[2 * c.lane]; cb[k] = ((const f32x4*)src)[2 * c.lane + 1]; ck[k] = c.cache_kpe[(size_t)idx * ROPE + c.lane]; } }
#pragma unroll
                for (int k = 0; k < 4; ++k) { const int idx = base + k * c.NGW;
                    if (idx < NSB * PAST) { const int b = idx / PAST, i = idx % PAST; const size_t kr = (size_t)KR_SAMPLE0 + (size_t)b * KRS + 64 + i;
                        ((u32x4*)(c.CKVA + kr * KVLORA))[c.lane] = (u32x4){pk2(ca[k].x, ca[k].y), pk2(ca[k].z, ca[k].w), pk2(cb[k].x, cb[k].y), pk2(cb[k].z, cb[k].w)};
                        c.KPEA[kr * ROPE + RPOS(c.lane)] = (bf16)f2bf(ck[k]); } }
            }
        }
    }
    for (int z = c.gw; z < (NB + NSB) * 48 + NSB * 32; z += c.NGW) {
        size_t kr;
        if (z < (NB + NSB) * 48) { const int s = z / 48, i = NMETA + z % 48; kr = s < NB ? (size_t)s * KRP + i : (size_t)KR_SAMPLE0 + (size_t)(s - NB) * KRS + i; }
        else { const int t = z - (NB + NSB) * 48, b = t >> 5; kr = (size_t)KR_SAMPLE0 + (size_t)b * KRS + 64 + PAST + LS + (t & 31); }
        ((u32x4*)(c.CKVA + kr * KVLORA))[c.lane] = (u32x4){0u, 0u, 0u, 0u}; c.KPEA[kr * ROPE + RPOS(c.lane)] = 0;
    }
}

__device__ __forceinline__ void p2_row(const Ctx& c, int r, const u32x4 (&v)[3], const u32x4 kvv, float kp, float cs, float sn, const f32x4 (&gq)[6], const f32x4 (&gkv)[2], float gkr) {
        if (r < XR_OUT) {
            float s = 0.f;
#pragma unroll
            for (int j = 0; j < 3; ++j) {
#pragma unroll
                for (int e = 0; e < 4; ++e) { const float a = bflo(v[j][e]), b = bfhi(v[j][e]); s += a * a + b * b; } }
            const float rs = rsqrtf(wave_sum(s) * (1.f / QLORA) + EPS);
#pragma unroll
            for (int j = 0; j < 3; ++j) { const f32x4 g0 = gq[2 * j], g1 = gq[2 * j + 1];
                u32x4 o; o.x = pk2(bflo(v[j].x) * rs * g0.x, bfhi(v[j].x) * rs * g0.y); o.y = pk2(bflo(v[j].y) * rs * g0.z, bfhi(v[j].y) * rs * g0.w);
                o.z = pk2(bflo(v[j].z) * rs * g1.x, bfhi(v[j].z) * rs * g1.y); o.w = pk2(bflo(v[j].w) * rs * g1.z, bfhi(v[j].w) * rs * g1.w);
                ((u32x4*)(c.CQN + (size_t)r * QLORA))[64 * j + c.lane] = o; }
        }
        float cv[8]; float s = 0.f;
        {
#pragma unroll
            for (int e = 0; e < 4; ++e) { cv[2 * e] = bflo(kvv[e]); cv[2 * e + 1] = bfhi(kvv[e]); s += cv[2 * e] * cv[2 * e] + cv[2 * e + 1] * cv[2 * e + 1]; } }
        const float rs = rsqrtf(wave_sum(s) * (1.f / KVLORA) + EPS);
        { const f32x4 g0 = gkv[0], g1 = gkv[1];
            cv[0] *= rs * g0.x; cv[1] *= rs * g0.y; cv[2] *= rs * g0.z; cv[3] *= rs * g0.w; cv[4] *= rs * g1.x; cv[5] *= rs * g1.y; cv[6] *= rs * g1.z; cv[7] *= rs * g1.w; }
        const float rk = rsqrtf(wave_sum(kp * kp) * (1.f / ROPE) + EPS);
        kp *= rk * gkr;
        { const float other = __shfl_xor(kp, 32); kp = c.lane < 32 ? kp * cs - other * sn : kp * cs + other * sn; }
        const u32x4 cb = (u32x4){pk2(cv[0], cv[1]), pk2(cv[2], cv[3]), pk2(cv[4], cv[5]), pk2(cv[6], cv[7])};
        const f32x4 c0 = (f32x4){cv[0], cv[1], cv[2], cv[3]}, c1 = (f32x4){cv[4], cv[5], cv[6], cv[7]};
        const bf16 kb = (bf16)f2bf(kp);
        if (r < XR_SAMPLE) {
            const int b = r >> 11, j = r & (SEQ - 1);
            float* oc = c.out + O_CKVP + ((size_t)b * TP + NMETA + j) * KVLORA; ((f32x4*)oc)[2 * c.lane] = c0; ((f32x4*)oc)[2 * c.lane + 1] = c1;
            c.out[O_KPEP + ((size_t)b * TP + NMETA + j) * ROPE + c.lane] = kp;
            const size_t kr = (size_t)b * KRP + 64 + j; ((u32x4*)(c.CKVA + kr * KVLORA))[c.lane] = cb; c.KPEA[kr * ROPE + RPOS(c.lane)] = kb;
        } else if (r < XR_META) {
            const int b = (r - XR_SAMPLE) >> 5, l = (r - XR_SAMPLE) & (LS - 1);
            float* oc = c.out + O_CKVS + ((size_t)b * LS + l) * KVLORA; ((f32x4*)oc)[2 * c.lane] = c0; ((f32x4*)oc)[2 * c.lane + 1] = c1;
            c.out[O_KPES + ((size_t)b * LS + l) * ROPE + c.lane] = kp;
            const size_t kr = (size_t)KR_SAMPLE0 + (size_t)b * KRS + 64 + PAST + l; ((u32x4*)(c.CKVA + kr * KVLORA))[c.lane] = cb; c.KPEA[kr * ROPE + RPOS(c.lane)] = kb;
        } else {
            const int m = r - XR_META;
            for (int b = 0; b < NB; ++b) { float* oc = c.out + O_CKVP + ((size_t)b * TP + m) * KVLORA; ((f32x4*)oc)[2 * c.lane] = c0; ((f32x4*)oc)[2 * c.lane + 1] = c1;
                c.out[O_KPEP + ((size_t)b * TP + m) * ROPE + c.lane] = kp;
                const size_t kr = (size_t)b * KRP + m; ((u32x4*)(c.CKVA + kr * KVLORA))[c.lane] = cb; c.KPEA[kr * ROPE + RPOS(c.lane)] = kb; }
            for (int b = 0; b < NSB; ++b) { const size_t kr = (size_t)KR_SAMPLE0 + (size_t)b * KRS + m; ((u32x4*)(c.CKVA + kr * KVLORA))[c.lane] = cb; c.KPEA[kr * ROPE + RPOS(c.lane)] = kb; }
        }
}
__device__ __forceinline__ void phase2_rows(const Ctx& c) {
    u32x4 qa[3], qb[3], kva, kvb; float kpa = 0.f, kpb = 0.f, csa = 0.f, sna = 0.f, csb = 0.f, snb = 0.f;
    f32x4 gq[6], gkv[2]; const float gkr = c.k_rope_norm[c.lane];
#pragma unroll
    for (int j = 0; j < 3; ++j) { gq[2 * j] = ((const f32x4*)c.q_a_norm)[2 * (64 * j + c.lane)]; gq[2 * j + 1] = ((const f32x4*)c.q_a_norm)[2 * (64 * j + c.lane) + 1]; }
    gkv[0] = ((const f32x4*)c.kv_a_norm)[2 * c.lane]; gkv[1] = ((const f32x4*)c.kv_a_norm)[2 * c.lane + 1];
#define P2_LOAD(Q, KV, KP, CS, SN, r_) do { if ((r_) < XR_REAL) { const bf16* prow_ = c.P + (size_t)(r_) * NP; \
        if ((r_) < XR_OUT) { _Pragma("unroll") for (int j = 0; j < 3; ++j) Q[j] = ((const u32x4*)(prow_ + PC_CQ))[64 * j + c.lane]; } \
        KV = ((const u32x4*)(prow_ + PC_CKV))[c.lane]; KP = c.G32[(size_t)(r_) * GP + GC_KPE + c.lane]; \
        const float* tb_ = (const float*)(c.ws + WS_SCAL + SC_TAB) + (size_t)xrow_pos(r_) * 64 + 2 * (c.lane & 31); CS = tb_[0]; SN = tb_[1]; } } while (0)
#define P2_ROW(Q, KV, KP, CS, SN, r_) do { if ((r_) < XR_REAL) p2_row(c, (r_), Q, KV, KP, CS, SN, gq, gkv, gkr); } while (0)
    int r = c.gw; P2_LOAD(qa, kva, kpa, csa, sna, r);
    for (; r < XR_REAL; r += 2 * c.NGW) {
        P2_LOAD(qb, kvb, kpb, csb, snb, r + c.NGW); P2_ROW(qa, kva, kpa, csa, sna, r);
        P2_LOAD(qa, kva, kpa, csa, sna, r + 2 * c.NGW); P2_ROW(qb, kvb, kpb, csb, snb, r + c.NGW);
    }
#undef P2_LOAD
#undef P2_ROW
}

namespace att {
using bf16x8 = __attribute__((ext_vector_type(8))) short;
using s16x4 = __attribute__((ext_vector_type(4))) short;
using f32x16 = __attribute__((ext_vector_type(16))) float;
constexpr int SHM_KN = 64 * 128 * 2, SHM_KR = 64 * 64 * 2, SHM_V = 64 * 128 * 2, SHM_BUF = SHM_KN + SHM_KR + SHM_V;
constexpr int OFF_WS = 2 * SHM_BUF;
constexpr float CEXP = ATTN_SCALE * 1.4426950408889634f;
constexpr float THR = 8.f;
#define ATT_KSWZ(row, colB) ((row) * 256 + ((colB) ^ (((row) & 15) << 4)))
#define ATT_RSWZ(row, ch) ((row) * 128 + ((((ch) ^ ((row) >> 1)) & 7) << 4))
#define ATT_SBAR() __builtin_amdgcn_sched_barrier(0)
__device__ __forceinline__ int crow(int r, int hi) { return (r & 3) + 8 * (r >> 2) + 4 * hi; }
__device__ __forceinline__ unsigned cvtpk(float lo, float hi) { unsigned r; asm volatile("v_cvt_pk_bf16_f32 %0, %1, %2" : "=v"(r) : "v"(lo), "v"(hi)); return r; }
__device__ __forceinline__ int v_st(int k, int c) { const int kk = (k & ~0xC) | ((k & 4) << 1) | ((k & 8) >> 1); return ((kk >> 3) * 4 + (c >> 5)) * 512 + ((kk & 7) * 32 + (c & 31)) * 2; }
__device__ __forceinline__ int v_rd_base(int lane) { return ((lane & 3) << 3) | (((lane >> 2) & 3) << 6) | (((lane >> 4) & 1) << 5) | (((lane >> 5) & 1) << 8); }
constexpr int v_rd_off(int d0, int ks, int half) { return d0 * 512 + ks * 4096 + half * 2048; }
template <int OFF> __device__ __forceinline__ s16x4 tr_read(int vb) { s16x4 r; asm volatile("ds_read_b64_tr_b16 %0, %1 offset:%2" : "=&v"(r) : "v"(vb), "i"(OFF) : "memory"); return r; }
template <int D0> __device__ __forceinline__ void pv_one(f32x16& od, int vb, bf16x8 pa0, bf16x8 pa1, bf16x8 pa2, bf16x8 pa3) {
    const s16x4 l0 = tr_read<v_rd_off(D0, 0, 0)>(vb), h0 = tr_read<v_rd_off(D0, 0, 1)>(vb), l1 = tr_read<v_rd_off(D0, 1, 0)>(vb), h1 = tr_read<v_rd_off(D0, 1, 1)>(vb);
    const s16x4 l2 = tr_read<v_rd_off(D0, 2, 0)>(vb), h2 = tr_read<v_rd_off(D0, 2, 1)>(vb), l3 = tr_read<v_rd_off(D0, 3, 0)>(vb), h3 = tr_read<v_rd_off(D0, 3, 1)>(vb);
    asm volatile("s_waitcnt lgkmcnt(0)" ::: "memory"); ATT_SBAR();
#define ATT_PK(L, H) (bf16x8){L[0], L[1], L[2], L[3], H[0], H[1], H[2], H[3]}
    od = __builtin_amdgcn_mfma_f32_32x32x16_bf16(pa0, ATT_PK(l0, h0), od, 0, 0, 0);
    od = __builtin_amdgcn_mfma_f32_32x32x16_bf16(pa1, ATT_PK(l1, h1), od, 0, 0, 0);
    od = __builtin_amdgcn_mfma_f32_32x32x16_bf16(pa2, ATT_PK(l2, h2), od, 0, 0, 0);
    od = __builtin_amdgcn_mfma_f32_32x32x16_bf16(pa3, ATT_PK(l3, h3), od, 0, 0, 0);
#undef ATT_PK
}
__device__ __forceinline__ int attn_run(const Ctx& c, unsigned char* lds, int u0, unsigned* qword, volatile LAS unsigned* misc) {
    const int tid = c.tid, wid = c.wave, lane = c.lane, r32 = lane & 31, hi = lane >> 5;
    float* wsf = (float*)(lds + OFF_WS) + wid * 64; float* li_l = wsf; float* al_l = wsf + 32;
    float m_reg, l_reg; f32x16 o[4]; bf16x8 qr[12];
    int xr0, h, kb, NT, wl, un; bool tailmask;
    const bf16* Kg; const bf16* Vg; const bf16* Rg;
#define ATT_DECODE(q_) do { const int u_ = (q_) < 448 ? (q_) : ((q_) < 576 ? (q_) + 64 : (q_) - 128);     \
        if ((u_) < 512) { const int qb_ = 7 - ((u_) >> 6), bh_ = (u_) & 63, b_ = bh_ >> 4; h = bh_ & 15; xr0 = b_ * SEQ + 256 * qb_; kb = b_ * KRP; NT = 4 * qb_ + 5; wl = 4 * qb_ + 1 + (wid >> 1); tailmask = false; } \
        else { const int t_ = (u_) - 512, b_ = t_ >> 4; h = t_ & 15; xr0 = XR_SAMPLE + b_ * LS; kb = KR_SAMPLE0 + b_ * KRS; NT = 18; wl = wid == 0 ? 17 : -1; tailmask = true; } \
        Kg = c.KV + (size_t)kb * KVP + h * NOPE; Vg = c.KV + (size_t)kb * KVP + 2048 + h * VH; Rg = c.KPEA + (size_t)kb * ROPE; } while (0)
#define ATT_QLOAD() do { const bf16* Qw = c.Q + (size_t)(xr0 + wid * 32 + r32) * QP; \
        if (wl >= 0) { _Pragma("unroll") for (int d0 = 0; d0 < 8; ++d0) qr[d0] = *(const bf16x8*)(Qw + h * NOPE + d0 * 16 + hi * 8); \
            _Pragma("unroll") for (int d0 = 0; d0 < 4; ++d0) qr[8 + d0] = *(const bf16x8*)(Qw + 2048 + h * ROPE + d0 * 16 + hi * 8); } \
        else { _Pragma("unroll") for (int d0 = 0; d0 < 12; ++d0) qr[d0] = (bf16x8){0, 0, 0, 0, 0, 0, 0, 0}; } } while (0)
    ATT_DECODE(u0); ATT_QLOAD();
    const int sr = tid >> 4, sc = (tid & 15) * 8, vst0 = v_st(sr, sc), vst1 = v_st(32 + sr, sc), rr = tid >> 3, rc = tid & 7;
    const int vb0 = (int)(uintptr_t)(lds + SHM_KN + SHM_KR) + v_rd_base(lane);
    bf16x8 sk0, sk1, sv0, sv1, skr;
#define ATT_SLOAD(k0) do { sk0 = *(const bf16x8*)(Kg + (size_t)((k0) + sr) * KVP + sc); sk1 = *(const bf16x8*)(Kg + (size_t)((k0) + 32 + sr) * KVP + sc); \
        sv0 = *(const bf16x8*)(Vg + (size_t)((k0) + sr) * KVP + sc); sv1 = *(const bf16x8*)(Vg + (size_t)((k0) + 32 + sr) * KVP + sc); \
        skr = *(const bf16x8*)(Rg + (size_t)((k0) + rr) * ROPE + rc * 8); } while (0)
#define ATT_SWRITE(b) do { unsigned char* B_ = lds + (b) * SHM_BUF; \
        *(bf16x8*)(B_ + ATT_KSWZ(sr, sc * 2)) = sk0; *(bf16x8*)(B_ + ATT_KSWZ(32 + sr, sc * 2)) = sk1; \
        *(bf16x8*)(B_ + SHM_KN + ATT_RSWZ(rr, rc)) = skr; \
        *(bf16x8*)(B_ + SHM_KN + SHM_KR + vst0) = sv0; *(bf16x8*)(B_ + SHM_KN + SHM_KR + vst1) = sv1; } while (0)
    ATT_SLOAD(0);
    for (;;) {
    m_reg = -1e30f; l_reg = 0.f;
#pragma unroll
    for (int d = 0; d < 4; ++d) o[d] = (f32x16){0.f, 0.f, 0.f, 0.f, 0.f, 0.f, 0.f, 0.f, 0.f, 0.f, 0.f, 0.f, 0.f, 0.f, 0.f, 0.f};
    ATT_SWRITE(0); __syncthreads();
    for (int j = 0; j < NT; ++j) {
        const int buf = j & 1;
        bf16x8 pa0, pa1, pa2, pa3;
        unsigned popv = 0u;
        if (j + 1 < NT) ATT_SLOAD((j + 1) * 64);
        else if (tid == 0) popv = __hip_atomic_fetch_add(qword, 1u, __ATOMIC_RELAXED, __HIP_MEMORY_SCOPE_AGENT);
        ATT_SBAR();
        if (j <= wl) {
            const unsigned char* Kn = lds + buf * SHM_BUF; const unsigned char* Kr = Kn + SHM_KN;
            f32x16 p0 = {}, p1 = {};
            int r32 = lane & 31, hi = lane >> 5; asm volatile("" : "+v"(r32), "+v"(hi));
#pragma unroll
            for (int d0 = 0; d0 < 8; ++d0) { const int cb = (d0 * 16 + hi * 8) * 2;
                const bf16x8 b0 = *(const bf16x8*)(Kn + ATT_KSWZ(r32, cb)), b1 = *(const bf16x8*)(Kn + ATT_KSWZ(32 + r32, cb));
                p0 = __builtin_amdgcn_mfma_f32_32x32x16_bf16(b0, qr[d0], p0, 0, 0, 0); p1 = __builtin_amdgcn_mfma_f32_32x32x16_bf16(b1, qr[d0], p1, 0, 0, 0);
                if ((d0 & 3) == 3) ATT_SBAR(); }
#pragma unroll
            for (int d0 = 0; d0 < 4; ++d0) { const int ch = d0 * 2 + hi;
                const bf16x8 b0 = *(const bf16x8*)(Kr + ATT_RSWZ(r32, ch)), b1 = *(const bf16x8*)(Kr + ATT_RSWZ(32 + r32, ch));
                p0 = __builtin_amdgcn_mfma_f32_32x32x16_bf16(b0, qr[8 + d0], p0, 0, 0, 0); p1 = __builtin_amdgcn_mfma_f32_32x32x16_bf16(b1, qr[8 + d0], p1, 0, 0, 0); }
            if (j == 0) {
#pragma unroll
                for (int r = 8; r < 16; ++r) p0[r] = -1e30f;
#pragma unroll
                for (int r = 0; r < 16; ++r) p1[r] = -1e30f;
            }
            if (tailmask && j == NT - 1) {
#pragma unroll
                for (int r = 0; r < 16; ++r) p1[r] = -1e30f;
            }
            float pmax = p0[0];
#pragma unroll
            for (int r = 1; r < 16; ++r) pmax = fmaxf(pmax, p0[r]);
#pragma unroll
            for (int r = 0; r < 16; ++r) pmax = fmaxf(pmax, p1[r]);
            { auto sw = __builtin_amdgcn_permlane32_swap(__float_as_uint(pmax), __float_as_uint(pmax), false, false); pmax = fmaxf(__uint_as_float(sw[0]), __uint_as_float(sw[1])); }
            float mn, alpha;
            if (__all(pmax - m_reg <= THR / ATTN_SCALE)) { mn = m_reg; alpha = 1.f; }
            else { mn = fmaxf(m_reg, pmax); alpha = __builtin_amdgcn_exp2f((m_reg - mn) * CEXP); m_reg = mn; }
            const float mnC = -mn * CEXP;
#pragma unroll
            for (int r = 0; r < 16; ++r) { p0[r] = __builtin_amdgcn_exp2f(fmaf(p0[r], CEXP, mnC)); p1[r] = __builtin_amdgcn_exp2f(fmaf(p1[r], CEXP, mnC)); }
            float ps = 0.f;
#pragma unroll
            for (int r = 0; r < 16; ++r) ps += p0[r] + p1[r];
            { auto sw = __builtin_amdgcn_permlane32_swap(__float_as_uint(ps), __float_as_uint(ps), false, false); ps = __uint_as_float(sw[0]) + __uint_as_float(sw[1]); }
            l_reg = l_reg * alpha + ps;
            if (__any(alpha < 1.f)) { if (hi == 0) al_l[r32] = alpha; asm volatile("s_waitcnt lgkmcnt(0)" ::: "memory");
#pragma unroll
                for (int d = 0; d < 4; ++d)
#pragma unroll
                    for (int r = 0; r < 16; ++r) o[d][r] *= al_l[crow(r, hi)]; }
#define ATT_PK4(P, BASE, OUT) do { unsigned a0 = cvtpk(P[BASE + 0], P[BASE + 1]), a1 = cvtpk(P[BASE + 2], P[BASE + 3]); \
        unsigned b0_ = cvtpk(P[BASE + 4], P[BASE + 5]), b1_ = cvtpk(P[BASE + 6], P[BASE + 7]); \
        auto r0 = __builtin_amdgcn_permlane32_swap(a0, b0_, false, false); auto r1 = __builtin_amdgcn_permlane32_swap(a1, b1_, false, false); \
        u32x4 w_ = {r0[0], r1[0], r0[1], r1[1]}; OUT = *reinterpret_cast<bf16x8*>(&w_); } while (0)
            ATT_PK4(p0, 0, pa0); ATT_PK4(p0, 8, pa1); ATT_PK4(p1, 0, pa2); ATT_PK4(p1, 8, pa3);
#undef ATT_PK4
            const int vb = vb0 + buf * SHM_BUF;
            pv_one<0>(o[0], vb, pa0, pa1, pa2, pa3); pv_one<1>(o[1], vb, pa0, pa1, pa2, pa3); pv_one<2>(o[2], vb, pa0, pa1, pa2, pa3); pv_one<3>(o[3], vb, pa0, pa1, pa2, pa3);
        }
        if (j + 1 < NT) ATT_SWRITE(buf ^ 1); else if (tid == 0) misc[0] = popv;
        __syncthreads();
    }
    un = (int)misc[0] + 208; const int cxr0 = xr0, hq = h, cwl = wl;
    if (un < 640) { ATT_DECODE(un); ATT_QLOAD(); ATT_SLOAD(0); }
    ATT_SBAR();
    if (cwl >= 0) {
        int r32 = lane & 31, hi = lane >> 5; asm volatile("" : "+v"(r32), "+v"(hi));
        if (hi == 0) li_l[r32] = l_reg; asm volatile("s_waitcnt lgkmcnt(0)" ::: "memory");
        const int rowb = cxr0 + wid * 32;
        bf16* stg = (bf16*)(lds + OFF_WS + 2048 + wid * 8192);
#pragma unroll
        for (int r = 0; r < 16; ++r) { const float il = __builtin_amdgcn_rcpf(li_l[crow(r, hi)]);
#pragma unroll
            for (int d0 = 0; d0 < 4; ++d0) stg[crow(r, hi) * 128 + d0 * 32 + r32] = (bf16)f2bf(o[d0][r] * il); }
        asm volatile("s_waitcnt lgkmcnt(0)" ::: "memory");
        u32x4 zv[8];
#pragma unroll
        for (int i = 0; i < 8; ++i) { const int idx = i * 64 + lane, row = idx >> 4, ch = idx & 15; zv[i] = *(const u32x4*)(c.P + (size_t)(rowb + row) * NP + PC_ZA + hq * VH + ch * 8); }
#pragma unroll
        for (int i = 0; i < 8; ++i) { const int idx = i * 64 + lane, row = idx >> 4, ch = idx & 15;
            const u32x4 ov = *(const u32x4*)(stg + row * 128 + ch * 8);
            u32x4 w;
#pragma unroll
            for (int e = 0; e < 4; ++e) w[e] = pk2(bflo(ov[e]) * siluf_(bflo(zv[i][e])), bfhi(ov[e]) * siluf_(bfhi(zv[i][e])));
            *(u32x4*)(c.MIX + (size_t)(rowb + row) * DM + hq * VH + ch * 8) = w; }
    }
    if (un >= 640) break;
    }
#undef ATT_SLOAD
#undef ATT_SWRITE
#undef ATT_DECODE
#undef ATT_QLOAD
    __syncthreads();
    return un;
}
}


namespace ml {
using bf16x8 = __attribute__((ext_vector_type(8))) short;
using s16x4 = __attribute__((ext_vector_type(4))) short;
using f32x16 = __attribute__((ext_vector_type(16))) float;
typedef short v4i16_t __attribute__((ext_vector_type(4)));
constexpr int NCI = 560;
constexpr size_t SC_WI = 512 * 1024;
__device__ __forceinline__ int crow(int r, int hi) { return (r & 3) + 8 * (r >> 2) + 4 * hi; }
__device__ __forceinline__ void chunk_info(int ci, int& seq, int& c, bool& prompt, int& b, int& h, int& xr0, int& nreal) {
    if (ci < 528) { prompt = true; seq = ci / 33; c = ci % 33; b = seq >> 2; h = seq & 3; if (c == 0) { xr0 = XR_META; nreal = NMETA; } else { xr0 = b * SEQ + 64 * (c - 1); nreal = 64; } }
    else { prompt = false; seq = ci - 528; c = 0; b = seq >> 2; h = seq & 3; xr0 = XR_SAMPLE + b * LS; nreal = LS; }
}
__device__ __forceinline__ float scan_add(float v, int) {
    v += DPPF(0.f, v, 0x111, 0xf, 0xf); v += DPPF(0.f, v, 0x112, 0xf, 0xf); v += DPPF(0.f, v, 0x114, 0xf, 0xf); v += DPPF(0.f, v, 0x118, 0xf, 0xf);
    v += DPPF(0.f, v, 0x142, 0xa, 0xf); v += DPPF(0.f, v, 0x143, 0xc, 0xf);
    return v;
}
__device__ __forceinline__ float scan_max(float v, int) {
    constexpr float NI = -3.0e38f;
    v = fmaxf(v, DPPF(NI, v, 0x111, 0xf, 0xf)); v = fmaxf(v, DPPF(NI, v, 0x112, 0xf, 0xf)); v = fmaxf(v, DPPF(NI, v, 0x114, 0xf, 0xf)); v = fmaxf(v, DPPF(NI, v, 0x118, 0xf, 0xf));
    v = fmaxf(v, DPPF(NI, v, 0x142, 0xa, 0xf)); v = fmaxf(v, DPPF(NI, v, 0x143, 0xc, 0xf));
    return v;
}
constexpr int PA_P = 528, PA_Q = 0, PA_K = 64 * PA_P, PA_XS = 2 * 64 * PA_P, PA_MB = PA_XS + 256, PA_WS = PA_MB + 256, PA_SUM = PA_WS + 256, PA_MAX = PA_SUM + 256;
__device__ __forceinline__ void passA_item(const Ctx& c, LAS unsigned char* lds, bool prompt, int seq, int cc) {
    bf16* SPb = (bf16*)(c.ws + WS_SP); bf16* KPb = (bf16*)(c.ws + WS_KP); float* WIb = (float*)(c.ws + WS_SCAL + SC_WI);
    const int tid = c.tid, lane = c.lane, w = c.wave, r32 = lane & 31, hi = lane >> 5;
    const int b = seq >> 2, h = seq & 3, ci = prompt ? seq * 33 + cc : 528 + seq;
    const int xr0 = prompt ? (cc == 0 ? XR_META : b * SEQ + 64 * (cc - 1)) : XR_SAMPLE + b * LS, nreal = prompt ? (cc == 0 ? NMETA : 64) : LS;
#pragma unroll
    for (int k = 0; k < 4; ++k) { const int ch = tid + 512 * k, row = ch >> 5, cx = ch & 31;
        const u32x4 qv = *(const u32x4*)(c.P + (size_t)(xr0 + row) * NP + PC_MQ + h * DQK + cx * 8), kv = *(const u32x4*)(c.P + (size_t)(xr0 + row) * NP + PC_MK + h * DQK + cx * 8);
        *(LAS u32x4*)(lds + PA_Q + row * PA_P + cx * 16) = qv; *(LAS u32x4*)(lds + PA_K + row * PA_P + cx * 16) = kv; }
    if (w == 0) {
        float Brun = 0.f, Mx = -1e30f;
        if (prompt) { const float sl = lane < cc ? *(const LAS float*)(lds + PA_SUM + lane * 4) : 0.f, ml = lane < cc ? *(const LAS float*)(lds + PA_MAX + lane * 4) : -1e30f;
            const float incl = scan_add(sl, lane); Brun = __shfl(incl, 63); Mx = wave_max(lane < cc ? ml - (incl - sl) : -1e30f); }
        const float bi = c.b_ig[h], bfg = c.b_fg[h], m0 = prompt ? 0.f : c.state_m[b * MLH + h];
        const bool real = lane < nreal; float lf = 0.f, ig = -1e30f;
        if (real) { ig = c.G32[(size_t)(xr0 + lane) * GP + GC_MI + h] + bi; lf = logsigmoidf_(c.G32[(size_t)(xr0 + lane) * GP + GC_MF + h] + bfg); }
        const float Bs = Brun + scan_add(lf, lane), xs = real ? ig - Bs : -1e30f;
        const float mb0 = fmaxf(m0, Mx), mb = fmaxf(m0, fmaxf(Mx, scan_max(xs, lane))), ms = Bs + mb, mb31 = __shfl(mb, 31), mb63 = __shfl(mb, 63);
        const float mb_prev = lane < 32 ? mb0 : mb31, mb_end = lane < 32 ? mb31 : mb63;
        *(LAS float*)(lds + PA_XS + lane * 4) = xs; *(LAS float*)(lds + PA_MB + lane * 4) = mb; *(LAS float*)(lds + PA_WS + lane * 4) = real ? __expf(xs - mb_end) * 0.0625f : 0.f;
        WIb[ci * 64 + lane] = __expf(mb_prev - mb);
        if (real) c.MTOK[(size_t)(xr0 + lane) * 4 + h] = ms;
        if ((!prompt || cc == 32) && lane == 63) c.out[(prompt ? O_MP : O_MS) + b * MLH + h] = ms;
    }
    __syncthreads();
    bf16* sp = SPb + (size_t)ci * 4096;
    if (w < 2) {
        f32x16 acc = {};
        const LAS unsigned char* qa = lds + PA_Q + (32 * w + r32) * PA_P + hi * 16; const LAS unsigned char* ka = lds + PA_K + (32 * w + r32) * PA_P + hi * 16;
#pragma unroll
        for (int kk = 0; kk < 16; ++kk) acc = __builtin_amdgcn_mfma_f32_32x32x16_bf16(*(const LAS bf16x8*)(qa + kk * 32), *(const LAS bf16x8*)(ka + kk * 32), acc, 0, 0, 0);
        const float xsv = *(const LAS float*)(lds + PA_XS + (32 * w + r32) * 4);
#pragma unroll
        for (int r = 0; r < 16; ++r) { const int t0 = crow(r, hi); const float mbv = *(const LAS float*)(lds + PA_MB + (32 * w + t0) * 4);
            const float v = r32 <= t0 ? __expf(xsv - mbv) * acc[r] * 0.0625f : 0.f;
            sp[w * 1024 + t0 * 32 + r32] = (bf16)f2bf(v); }
    }
    bf16* kp = KPb + (size_t)ci * 16384;
#pragma unroll
    for (int k = 0; k < 4; ++k) { const int ch = tid + 512 * k, row = ch >> 5, cx = ch & 31; const float wv = *(const LAS float*)(lds + PA_WS + row * 4);
        const u32x4 kv = *(const LAS u32x4*)(lds + PA_K + row * PA_P + cx * 16);
        u32x4 o; o.x = pk2(bflo(kv.x) * wv, bfhi(kv.x) * wv); o.y = pk2(bflo(kv.y) * wv, bfhi(kv.y) * wv); o.z = pk2(bflo(kv.z) * wv, bfhi(kv.z) * wv); o.w = pk2(bflo(kv.w) * wv, bfhi(kv.w) * wv);
        *(u32x4*)(kp + row * 256 + cx * 8) = o; }
    __syncthreads();
}
__device__ __forceinline__ void passA(const Ctx& c, LAS unsigned char* lds) {
    const int lane = c.lane, w = c.wave, seq = c.blk & 15, slot = c.blk >> 4, b = seq >> 2, h = seq & 3;
    if (c.blk < 256) {
        const float bi = c.b_ig[h], bfg = c.b_fg[h];
        for (int cc = w; cc < 33; cc += 8) {
            const int xr0 = cc == 0 ? XR_META : b * SEQ + 64 * (cc - 1), nreal = cc == 0 ? NMETA : 64;
            float lf = 0.f, ig = -1e30f;
            if (lane < nreal) { ig = c.G32[(size_t)(xr0 + lane) * GP + GC_MI + h] + bi; lf = logsigmoidf_(c.G32[(size_t)(xr0 + lane) * GP + GC_MF + h] + bfg); }
            const float Bl = scan_add(lf, lane), mx = wave_max(lane < nreal ? ig - Bl : -1e30f), tot = __shfl(Bl, 63);
            if (lane == 0) { *(LAS float*)(lds + PA_SUM + cc * 4) = tot; *(LAS float*)(lds + PA_MAX + cc * 4) = mx; }
        }
        __syncthreads();
        for (int cc = slot; cc < 33; cc += 16) passA_item(c, lds, true, seq, cc);
        const int j = 255 - c.blk; if (j < 32) passA_item(c, lds, false, j, 0);
    }
}
constexpr int QT_P = 520, KT_P = 576, ST_P = 80;
constexpr int L_Q = 0, L_K = 32 * QT_P, L_V = L_K + 32 * KT_P, L_S = L_V + 32 * KT_P, L_W = L_S + 32 * ST_P, L_STAGE = L_W + 128, L_END = 2 * L_STAGE;
static_assert(L_END <= 150016 && L_STAGE % 16 == 0, "pass B LDS map must stay below the LDS control words");
__device__ __forceinline__ s16x4 vtr(const LAS unsigned char* p) { return __builtin_bit_cast(s16x4, __builtin_amdgcn_ds_read_tr16_b64_v4i16((LAS v4i16_t*)p)); }
__device__ __forceinline__ void passB_unit(const Ctx& c, LAS unsigned char* lds, int seq, bool prompt, int kind) {
    const int tid = c.tid, lane = c.lane, w = c.wave, r32 = lane & 31, hi = lane >> 5;
    const int b = seq >> 2, h = seq & 3, ci0 = prompt ? seq * 33 : 528 + seq;
    const bool ones = kind == 2; const int dv0 = (ones ? 0 : kind * 256) + 32 * w;
    const bool active = !ones || w == 0;
    const bf16* SPb = (const bf16*)(c.ws + WS_SP); const bf16* KPb = (const bf16*)(c.ws + WS_KP); const float* WIb = (const float*)(c.ws + WS_SCAL + SC_WI);
    f32x16 cacc[8];
    {   const float* sC = c.state_C + ((size_t)b * MLH + h) * DQK * DV; const float* sN = c.state_n + ((size_t)b * MLH + h) * DQK;
        unsigned lo_c = (unsigned)((4 * hi) * DV + dv0 + r32), lo_n = (unsigned)(4 * hi);
#pragma unroll
        for (int i = 0; i < 8; ++i) {
            asm volatile("" : "+v"(lo_c), "+v"(lo_n));
#pragma unroll
            for (int r = 0; r < 16; ++r) {
                float v = 0.f; const int dkc = 32 * i + (r & 3) + 8 * (r >> 2);
                if (!prompt) { if (!ones) v = sC[lo_c + dkc * DV]; else if (w == 0 && r32 == 0) v = sN[lo_n + dkc]; }
                cacc[i][r] = v; }
            __builtin_amdgcn_sched_barrier(0);
        } }
    const int NS = prompt ? 65 : 1;
    u32x4 sq0, sq1, sk0, sk1, sv0 = {0u, 0u, 0u, 0u}, sv1 = {0u, 0u, 0u, 0u}, ss = {0u, 0u, 0u, 0u}; float swi = 0.f;
#define ML_CC(k_) ((k_) == 0 ? 0 : ((k_) + 1) >> 1)
#define ML_JJ(k_) ((k_) == 0 ? 0 : ((k_) + 1) & 1)
#define ML_XR0(k_) ((prompt ? (ML_CC(k_) == 0 ? XR_META : b * SEQ + 64 * (ML_CC(k_) - 1)) : XR_SAMPLE + b * LS) + 32 * ML_JJ(k_))
#define ML_BAR() do { asm volatile("s_waitcnt lgkmcnt(0)" ::: "memory"); __builtin_amdgcn_s_barrier(); asm volatile("" ::: "memory"); } while (0)
#define ML_LOAD(k_) do { const int ci_ = ci0 + ML_CC(k_), jj_ = ML_JJ(k_), x0_ = ML_XR0(k_); int tq = tid; asm volatile("" : "+v"(tq)); \
        const int r0_ = tq >> 5, cx_ = tq & 31; \
        sq0 = *(const u32x4*)(c.P + (size_t)(x0_ + r0_) * NP + PC_MQ + h * DQK + cx_ * 8); sq1 = *(const u32x4*)(c.P + (size_t)(x0_ + 16 + r0_) * NP + PC_MQ + h * DQK + cx_ * 8); \
        sk0 = *(const u32x4*)(KPb + (size_t)ci_ * 16384 + (32 * jj_ + r0_) * 256 + cx_ * 8); sk1 = *(const u32x4*)(KPb + (size_t)ci_ * 16384 + (32 * jj_ + 16 + r0_) * 256 + cx_ * 8); \
        if (!ones) { sv0 = *(const u32x4*)(c.P + (size_t)(x0_ + r0_) * NP + PC_MV + h * DV + kind * 256 + cx_ * 8); sv1 = *(const u32x4*)(c.P + (size_t)(x0_ + 16 + r0_) * NP + PC_MV + h * DV + kind * 256 + cx_ * 8); } \
        if (tq < 128) ss = *(const u32x4*)(SPb + (size_t)ci_ * 4096 + jj_ * 1024 + (tq >> 2) * 32 + (tq & 3) * 8); if (tq < 32) swi = WIb[ci_ * 64 + 32 * jj_ + tq]; } while (0)
#define ML_WRITE(st_) do { int tq = tid; asm volatile("" : "+v"(tq)); const int r0_ = tq >> 5, cx_ = tq & 31; LAS unsigned char* B_ = lds + (st_) * L_STAGE; \
        *(LAS u32x2*)(B_ + L_Q + r0_ * QT_P + cx_ * 16) = (u32x2){sq0.x, sq0.y}; *(LAS u32x2*)(B_ + L_Q + r0_ * QT_P + cx_ * 16 + 8) = (u32x2){sq0.z, sq0.w}; \
        *(LAS u32x2*)(B_ + L_Q + (16 + r0_) * QT_P + cx_ * 16) = (u32x2){sq1.x, sq1.y}; *(LAS u32x2*)(B_ + L_Q + (16 + r0_) * QT_P + cx_ * 16 + 8) = (u32x2){sq1.z, sq1.w}; \
        *(LAS u32x4*)(B_ + L_K + r0_ * KT_P + cx_ * 16) = sk0; *(LAS u32x4*)(B_ + L_K + (16 + r0_) * KT_P + cx_ * 16) = sk1; \
        if (!ones) { *(LAS u32x4*)(B_ + L_V + r0_ * KT_P + cx_ * 16) = sv0; *(LAS u32x4*)(B_ + L_V + (16 + r0_) * KT_P + cx_ * 16) = sv1; } \
        if (tq < 128) *(LAS u32x4*)(B_ + L_S + (tq >> 2) * ST_P + (tq & 3) * 16) = ss; if (tq < 32) *(LAS float*)(B_ + L_W + tq * 4) = swi; } while (0)
    __syncthreads();
    if (ones) {
        for (int i = tid; i < 2 * 32 * 36; i += 512) { const int st = i / (32 * 36), row = (i % (32 * 36)) / 36, ch = i % 36; *(LAS u32x4*)(lds + st * L_STAGE + L_V + row * KT_P + ch * 16) = (u32x4){ch == 0 ? 0x3F80u : 0u, 0u, 0u, 0u}; }
    }
    ML_LOAD(0); ML_WRITE(0);
    ML_BAR();
    for (int k = 0; k < NS; ++k) {
        const int xr0 = ML_XR0(k), nreal = (prompt && k == 0) ? NMETA : 32;
        LAS unsigned char* const S_ = lds + (k & 1) * L_STAGE;
        if (k + 1 < NS) ML_LOAD(k + 1);
        __builtin_amdgcn_sched_barrier(0);
        if (active) {
            int lq = lane; asm volatile("" : "+v"(lq)); const int r32 = lq & 31, hi = lq >> 5;
            f32x16 hacc = {};
            u32x2 qa[2][2];
#define ML_QLD(n_) do { const LAS unsigned char* qp = S_ + L_Q + r32 * QT_P + (16 * (n_) + 4 * hi) * 2; qa[(n_) & 1][0] = *(const LAS u32x2*)qp; qa[(n_) & 1][1] = *(const LAS u32x2*)(qp + 16); } while (0)
            ML_QLD(0);
#pragma unroll
            for (int n = 0; n < 16; ++n) {
                const int i = n >> 1, s = n & 1;
                if (n + 1 < 16) ML_QLD(n + 1);
                u32x4 cw; cw.x = pg8::cvt_pk_bf16(cacc[i][8 * s + 0], cacc[i][8 * s + 1]); cw.y = pg8::cvt_pk_bf16(cacc[i][8 * s + 2], cacc[i][8 * s + 3]);
                cw.z = pg8::cvt_pk_bf16(cacc[i][8 * s + 4], cacc[i][8 * s + 5]); cw.w = pg8::cvt_pk_bf16(cacc[i][8 * s + 6], cacc[i][8 * s + 7]);
                const bf16x8 cf = __builtin_bit_cast(bf16x8, cw);
                const bf16x8 qf = __builtin_bit_cast(bf16x8, (u32x4){qa[n & 1][0].x, qa[n & 1][0].y, qa[n & 1][1].x, qa[n & 1][1].y});
                hacc = __builtin_amdgcn_mfma_f32_32x32x16_bf16(qf, cf, hacc, 0, 0, 0);
                __builtin_amdgcn_sched_barrier(0);
            }
#undef ML_QLD
#pragma unroll
            for (int r = 0; r < 16; ++r) hacc[r] *= *(const LAS float*)(S_ + L_W + crow(r, hi) * 4);
            const int troff = (8 * hi + ((lq & 15) >> 2)) * KT_P + (16 * ((lq >> 4) & 1) + 4 * (lq & 3)) * 2;
            bf16x8 vf[2];
#pragma unroll
            for (int kk = 0; kk < 2; ++kk) { const LAS unsigned char* vp = S_ + L_V + troff + (16 * kk) * KT_P + (32 * w) * 2;
                const s16x4 lo = vtr(vp), hi4 = vtr(vp + 4 * KT_P); vf[kk] = (bf16x8){lo[0], lo[1], lo[2], lo[3], hi4[0], hi4[1], hi4[2], hi4[3]}; }
#pragma unroll
            for (int kk = 0; kk < 2; ++kk) { const bf16x8 sf = *(const LAS bf16x8*)(S_ + L_S + r32 * ST_P + (16 * kk + 8 * hi) * 2);
                hacc = __builtin_amdgcn_mfma_f32_32x32x16_bf16(sf, vf[kk], hacc, 0, 0, 0); }
            {   bf16* nb = c.NUM + (size_t)xr0 * 2048 + h * DV; float* db = c.DEN + (size_t)xr0 * 4 + h;
                unsigned lo_n = (unsigned)((4 * hi) * 2048 + dv0 + r32), lo_d = (unsigned)((4 * hi) * 4);
                asm volatile("" : "+v"(lo_n), "+v"(lo_d));
                if (!ones) {
                    if (nreal == 32) {
#pragma unroll
                        for (int r = 0; r < 16; ++r) { const int tc = (r & 3) + 8 * (r >> 2); nb[lo_n + tc * 2048] = (bf16)f2bf(hacc[r]); }
                    } else {
#pragma unroll
                        for (int r = 0; r < 16; ++r) { const int tc = (r & 3) + 8 * (r >> 2), t = tc + 4 * hi; if (t < nreal) nb[lo_n + tc * 2048] = (bf16)f2bf(hacc[r]); }
                    }
                } else if (r32 == 0) {
#pragma unroll
                    for (int r = 0; r < 16; ++r) { const int tc = (r & 3) + 8 * (r >> 2), t = tc + 4 * hi; if (t < nreal) db[lo_d + tc * 4] = hacc[r]; }
                }
                __builtin_amdgcn_sched_barrier(0); }
            const float decay = *(const LAS float*)(S_ + L_W + 31 * 4);
            s16x4 ka[3][2];
#define ML_KLD(n_) do { const LAS unsigned char* kp_ = S_ + L_K + troff + (16 * ((n_) & 1)) * KT_P + (32 * ((n_) >> 1)) * 2; ka[(n_) % 3][0] = vtr(kp_); ka[(n_) % 3][1] = vtr(kp_ + 4 * KT_P); } while (0)
            ML_KLD(0); ML_KLD(1);
#define ML_DECAY(blk_) do { _Pragma("unroll") for (int r = 0; r < 16; ++r) { float t_ = cacc[blk_][r]; asm("v_mul_f32 %0, %1, %0" : "+v"(t_) : "v"(decay)); cacc[blk_][r] = t_; } } while (0)
            ML_DECAY(0);
#pragma unroll
            for (int n = 0; n < 16; ++n) {
                const int i = n >> 1, kk = n & 1;
                if (n + 2 < 16) ML_KLD(n + 2);
                const bf16x8 kf = (bf16x8){ka[n % 3][0][0], ka[n % 3][0][1], ka[n % 3][0][2], ka[n % 3][0][3], ka[n % 3][1][0], ka[n % 3][1][1], ka[n % 3][1][2], ka[n % 3][1][3]};
                cacc[i] = __builtin_amdgcn_mfma_f32_32x32x16_bf16(kf, vf[kk], cacc[i], 0, 0, 0);
                if (kk == 0 && i + 1 < 8) ML_DECAY(i + 1);
                __builtin_amdgcn_sched_barrier(0);
            }
#undef ML_KLD
#undef ML_DECAY
        }
        if (k + 1 < NS) ML_WRITE((k + 1) & 1);
        ML_BAR();
    }
#undef ML_CC
#undef ML_JJ
#undef ML_XR0
#undef ML_BAR
#undef ML_LOAD
#undef ML_WRITE
    if (active) {
        float* oc = c.out + (prompt ? O_CP : O_CS) + ((size_t)b * MLH + h) * DQK * DV; float* on = c.out + (prompt ? O_NP : O_NS) + ((size_t)b * MLH + h) * DQK;
        unsigned lo_c = (unsigned)((4 * hi) * DV + dv0 + r32), lo_n = (unsigned)(4 * hi);
#pragma unroll
        for (int i = 0; i < 8; ++i) {
            asm volatile("" : "+v"(lo_c), "+v"(lo_n));
#pragma unroll
            for (int r = 0; r < 16; ++r) { const int dkc = 32 * i + (r & 3) + 8 * (r >> 2);
                if (!ones) oc[lo_c + dkc * DV] = cacc[i][r]; else if (r32 == 0) on[lo_n + dkc] = cacc[i][r]; }
            __builtin_amdgcn_sched_barrier(0);
        }
    }
    __syncthreads();
}
}

__device__ __forceinline__ void phase5(const Ctx& c) {
    constexpr int N = XR_OUT * MLH;
#define P5_LOAD(k_, it_) do { const int r_ = (it_) >> 2, h_ = (it_) & 3; den[k_] = c.DEN[(size_t)r_ * 4 + h_]; mt[k_] = c.MTOK[(size_t)r_ * 4 + h_]; \
        nv[k_] = ((const u32x4*)(c.NUM + (size_t)r_ * 2048 + h_ * DV))[c.lane]; mo[k_] = ((const u32x4*)(c.P + (size_t)r_ * NP + PC_MO + h_ * DV))[c.lane]; zb[k_] = ((const u32x4*)(c.P + (size_t)r_ * NP + PC_ZB + h_ * DV))[c.lane]; } while (0)
#define P5_DO(k_, it_) do { const int r_ = (it_) >> 2, h_ = (it_) & 3; const float inv = 1.f / fmaxf(fabsf(den[k_]), __expf(-mt[k_])); \
        f32x4 a = (f32x4){bflo(nv[k_].x), bfhi(nv[k_].x), bflo(nv[k_].y), bfhi(nv[k_].y)}, b = (f32x4){bflo(nv[k_].z), bfhi(nv[k_].z), bflo(nv[k_].w), bfhi(nv[k_].w)}; a *= inv; b *= inv; \
        const float ss = wave_sum((a.x * a.x + a.y * a.y) + (a.z * a.z + a.w * a.w) + (b.x * b.x + b.y * b.y) + (b.z * b.z + b.w * b.w)); \
        const float rs = rsqrtf(ss * (1.f / DV) + EPS); \
        const f32x4 g0 = h_ == 0 ? mg[0] : (h_ == 1 ? mg[2] : (h_ == 2 ? mg[4] : mg[6])), g1 = h_ == 0 ? mg[1] : (h_ == 1 ? mg[3] : (h_ == 2 ? mg[5] : mg[7])); \
        float v[8] = {a.x * rs * g0.x, a.y * rs * g0.y, a.z * rs * g0.z, a.w * rs * g0.w, b.x * rs * g1.x, b.y * rs * g1.y, b.z * rs * g1.z, b.w * rs * g1.w}; \
        u32x4 o; \
        _Pragma("unroll") for (int e = 0; e < 4; ++e) { const float x0 = v[2 * e] * sigmoidf_(bflo(mo[k_][e])) * siluf_(bflo(zb[k_][e])), x1 = v[2 * e + 1] * sigmoidf_(bfhi(mo[k_][e])) * siluf_(bfhi(zb[k_][e])); o[e] = pk2(x0, x1); } \
        ((u32x4*)(c.MIX + (size_t)r_ * DM + 2048 + h_ * DV))[c.lane] = o; } while (0)
    float den[4], mt[4]; u32x4 nv[4], mo[4], zb[4];
    f32x4 mg[8];
#pragma unroll
    for (int hh = 0; hh < 4; ++hh) { mg[2 * hh] = ((const f32x4*)(c.ml_out_norm + hh * DV))[2 * c.lane]; mg[2 * hh + 1] = ((const f32x4*)(c.ml_out_norm + hh * DV))[2 * c.lane + 1]; }
    int it = c.gw;
    for (; it + 3 * c.NGW < N; it += 4 * c.NGW) {
#pragma unroll
        for (int k = 0; k < 4; ++k) P5_LOAD(k, it + k * c.NGW);
#pragma unroll
        for (int k = 0; k < 4; ++k) P5_DO(k, it + k * c.NGW);
    }
    for (; it < N; it += c.NGW) { P5_LOAD(0, it); P5_DO(0, it); }
#undef P5_LOAD
#undef P5_DO
}

__device__ __forceinline__ Ctx make_ctx(const Args& a) {
    Ctx c;
    c.x_prompt = a.in[0]; c.x_sample = a.in[1]; c.cache_ckv = a.in[2]; c.cache_kpe = a.in[3]; c.state_C = a.in[4]; c.state_n = a.in[5]; c.state_m = a.in[6]; c.meta = a.in[7];
    c.norm_gain = a.in[8]; c.w_in = a.in[9]; c.b_ig = a.in[10]; c.b_fg = a.in[11]; c.q_a_norm = a.in[12]; c.w_q_up = a.in[13]; c.q_nope_norm = a.in[14]; c.q_rope_norm = a.in[15];
    c.kv_a_norm = a.in[16]; c.k_rope_norm = a.in[17]; c.w_kv_up = a.in[18]; c.k_nope_norm = a.in[19]; c.ml_out_norm = a.in[20]; c.w_out = a.in[21];
    c.out = a.out; c.ws = a.ws;
    c.XN = (bf16*)(a.ws + WS_XN); c.P = (bf16*)(a.ws + WS_P); c.CQN = (bf16*)(a.ws + WS_CQN); c.CKVA = (bf16*)(a.ws + WS_CKVA); c.KPEA = (bf16*)(a.ws + WS_KPEA);
    c.Q = (bf16*)(a.ws + WS_Q); c.KV = (bf16*)(a.ws + WS_KV); c.MIX = (bf16*)(a.ws + WS_MIX);
    c.G32 = (float*)(a.ws + WS_G32); c.NUM = (bf16*)(a.ws + WS_NUM); c.DEN = (float*)(a.ws + WS_SCAL + SC_DEN); c.MTOK = (float*)(a.ws + WS_SCAL + SC_MTOK); c.CST = (float*)(a.ws + WS_CST);
    c.tid = threadIdx.x; c.lane = c.tid & 63; c.wave = __builtin_amdgcn_readfirstlane(c.tid >> 6); c.nblk = gridDim.x; c.blk = blockIdx.x; c.gw = c.blk * 8 + c.wave; c.NGW = c.nblk * 8;
    return c;
}

constexpr int LDS_BYTES = 150528, MISC_OFF = 150016;
constexpr int CW_BAR = 4096, CW_QUEUE = 64;
__global__ void __launch_bounds__(512, 2) mk(Args a) {
    extern __shared__ __attribute__((aligned(16))) unsigned char lds[];
    const int lo = a.ph_lo, hi = a.ph_hi;
    volatile LAS unsigned* MISC = (volatile LAS unsigned*)((LAS unsigned char*)lds + MISC_OFF);
    if (threadIdx.x < 16) MISC[threadIdx.x] = 0u;
    __syncthreads();
    const XcdBarrier xbar = xcd_barrier_post((unsigned*)(a.ws + WS_CTL) + CW_BAR, MISC + 8);
#define IN(k) (lo <= (k) && (k) < hi)
#define SEAM(k) do { if (IN(k) && IN((k) + 1)) xcd_barrier(xbar); } while (0)
    if (IN(0)) { const Ctx c = make_ctx(a); phase0(c);
        LAS unsigned* scr = (LAS unsigned*)((LAS unsigned char*)lds) + c.wave * 2112;
        {   static_assert(RO_PRE == 2 && XR_PAD == 8704, "phase-0 balance is written for 3584 items and 8704 rows on 2048 waves");
            constexpr int NB = RO_TPR * 4, NBA = NPT / 64, NIR = (DM / 64) * NB;
#define P0_ITEM(it_) do { const int it__ = (it_), r__ = it__ / NIR, rem__ = it__ % NIR; transpose_item(c.w_in, IN_COLS, DM, (bf16*)(a.ws + WS_WIN), scr, (rem__ / NB) * NBA + NB * r__ + rem__ % NB, NBA, c.lane, cmap_win); } while (0)
            if (c.NGW == 2048) { if (c.wave >= 2) { const int q = c.blk * 6 + c.wave - 2; P0_ITEM(q); P0_ITEM(q + 1536); } else P0_ITEM(3072 + c.blk * 2 + c.wave); }
            else for (int it = c.gw; it < RO_PRE * NIR; it += c.NGW) P0_ITEM(it);
#undef P0_ITEM
        }
        __syncthreads(); }
    SEAM(0);
    if (IN(1)) {
        const Ctx c = make_ctx(a);
        pg8::Gemm g{c.XN, (const bf16*)(a.ws + WS_WIN), XR_PAD, NPT, DM}; RoundOrder S; S.init(c.blk, (unsigned*)(a.ws + WS_CTL) + CW_ROUND, (LAS unsigned*)((LAS unsigned char*)lds + 139264) + c.wave * 64);
        EpiProj E{c.P, c.G32};
        pg8::gemm_phase<EpiProj, RoundOrder, true, true>((LAS unsigned char*)lds, g, S, E);
        if (c.blk >= RO_GEMM) {
            LAS unsigned* scr = (LAS unsigned*)((LAS unsigned char*)lds) + c.wave * 2112;
            for (int r = RO_PRE; r < 7; ++r) {
                convert_win_round(c.w_in, (bf16*)(a.ws + WS_WIN), scr, r, (c.blk - RO_GEMM) * 8 + c.wave, RO_NEED, c.lane);
                __builtin_amdgcn_fence(__ATOMIC_RELEASE, "agent");
                if (c.lane == 0) __hip_atomic_fetch_add((unsigned*)(a.ws + WS_CTL) + CW_ROUND + 32 * r, 1u, __ATOMIC_RELAXED, __HIP_MEMORY_SCOPE_AGENT);
            }
            { Ctx cs = c; cs.blk = c.blk - RO_GEMM; cs.gw = cs.blk * 8 + c.wave; cs.NGW = RO_NEED; phase0_side(cs); }
        }
        {   LAS unsigned* scr = (LAS unsigned*)((LAS unsigned char*)lds) + c.wave * 2112;
            constexpr int NQ = (QLORA / 64) * (QP / 64), NKVI = (KVLORA / 64) * (KVP / 64), NO = (DM / 64) * (DM / 64), NALL = NQ + NKVI + NO;
            unsigned* qw = (unsigned*)(a.ws + WS_CTL) + CW_QUEUE + 192;
            for (;;) {
                int base = 0; if (c.lane == 0) base = (int)__hip_atomic_fetch_add(qw, 8u, __ATOMIC_RELAXED, __HIP_MEMORY_SCOPE_AGENT);
                base = __builtin_amdgcn_readfirstlane(base); if (base >= NALL) break;
                for (int it = base; it < base + 8 && it < NALL; ++it) {
                    if (it < NQ) transpose_item<true>(c.w_q_up, 3072, QLORA, (bf16*)(a.ws + WS_WQ), scr, it, QP / 64, c.lane, cmap_wq);
                    else if (it < NQ + NKVI) transpose_item(c.w_kv_up, 4096, KVLORA, (bf16*)(a.ws + WS_WKV), scr, it - NQ, KVP / 64, c.lane, cmap_wkv);
                    else transpose_item(c.w_out, DM, DM, (bf16*)(a.ws + WS_WOUT), scr, it - NQ - NKVI, DM / 64, c.lane, cmap_id);
                }
            }
            __syncthreads(); }
    }
    SEAM(1);
    if (IN(2)) { const Ctx c = make_ctx(a); phase2_rows(c);
        ml::passA(c, (LAS unsigned char*)lds);
    }
    SEAM(2);
    if (IN(3)) {
        const Ctx c = make_ctx(a);
        { pg8::Gemm g{c.CQN, (const bf16*)(a.ws + WS_WQ), XR_OUT, QP, QLORA}; pg8::StaticOrder S; S.init(XR_OUT, QP, c.nblk, c.blk);
          EpiQ E{a.ws, (LAS float*)((LAS unsigned char*)lds + 131072)}; pg8::gemm_phase<EpiQ, pg8::StaticOrder, true, true>((LAS unsigned char*)lds, g, S, E); }
        { pg8::Gemm g{c.CKVA, (const bf16*)(a.ws + WS_WKV), NKR, KVP, KVLORA}; SplitOrder S; S.init(NKR, KVP, c.nblk, c.blk);
          EpiKV E{c.KV, c.k_nope_norm, (LAS float*)((LAS unsigned char*)lds + 131072)}; pg8::gemm_phase<EpiKV, SplitOrder, true, true>((LAS unsigned char*)lds, g, S, E); }
    }
    SEAM(3);
#define POP(word) do { if (threadIdx.x == 0) MISC[0] = __hip_atomic_fetch_add((unsigned*)(a.ws + WS_CTL) + (word), 1u, __ATOMIC_RELAXED, __HIP_MEMORY_SCOPE_AGENT); \
        __syncthreads(); u = (int)MISC[0]; __syncthreads(); } while (0)
    if (IN(5)) { const Ctx c = make_ctx(a);
        if (c.blk < 48) { const int u = c.blk;
            if (u < 32) ml::passB_unit(c, (LAS unsigned char*)lds, u >> 1, true, u & 1); else ml::passB_unit(c, (LAS unsigned char*)lds, u - 32, true, 2); }
    }
    if (IN(5)) { const Ctx c = make_ctx(a);
        unsigned* qa = (unsigned*)(a.ws + WS_CTL) + CW_QUEUE + 64;
        int u; if (c.blk >= 48) u = c.blk - 48; else { POP(CW_QUEUE + 64); u += 208; }
        if (u < 640) u = att::attn_run(c, lds, u, qa, MISC);
        while (u < 736) {
            ml::passB_unit(c, (LAS unsigned char*)lds, (u - 640) / 3, false, (u - 640) % 3);
            POP(CW_QUEUE + 64); u += 208; }
    }
#undef POP
    SEAM(5);
    if (IN(6)) { const Ctx c = make_ctx(a); phase5(c); }
    SEAM(6);
    if (IN(7)) {
        const Ctx c = make_ctx(a);
        pg8::Gemm g{c.MIX, (const bf16*)(a.ws + WS_WOUT), XR_SAMPLE, DM, DM}; pg8::StaticOrder S; S.init(XR_SAMPLE, DM, c.nblk, c.blk);
        EpiY E{c.x_prompt, c.x_sample, c.out};
        const bool first = (c.blk >> 3) & 1;
        if (first) skinny_out(c, (LAS unsigned char*)lds, (const bf16*)(a.ws + WS_WOUT));
        pg8::gemm_phase<EpiY, pg8::StaticOrder, true, true>((LAS unsigned char*)lds, g, S, E);
        if (!first) skinny_out(c, (LAS unsigned char*)lds, (const bf16*)(a.ws + WS_WOUT));
    }
#undef IN
#undef SEAM
}

extern "C" void kernel_launch(void* const* d_in, const int* in_sizes, int n_in, void* d_out, int out_size, void* d_ws, size_t ws_size, hipStream_t stream) {
    static int grid = 0;
    if (grid == 0) {
        if (n_in != 22 || out_size != (int)O_END || ws_size < WS_END) { fprintf(stderr, "kernel_launch: unexpected shapes: n_in %d out %d ws %zu (need %zu)\n", n_in, out_size, ws_size, (size_t)WS_END); grid = -1; return; }
        int dev = 0, cus = 0, per = 0; hipGetDevice(&dev); hipDeviceGetAttribute(&cus, hipDeviceAttributeMultiprocessorCount, dev);
        hipFuncSetAttribute((const void*)mk, hipFuncAttributeMaxDynamicSharedMemorySize, LDS_BYTES);
        hipOccupancyMaxActiveBlocksPerMultiprocessor(&per, (const void*)mk, 512, LDS_BYTES);
        grid = cus * per; fprintf(stderr, "kernel_launch: cus %d per_cu %d grid %d ws %zu\n", cus, per, grid, ws_size);
        if (grid != 256) { fprintf(stderr, "kernel_launch: this kernel is laid out for a 256-workgroup grid (one per CU); got %d\n", grid); grid = -1; return; }
    }
    if (grid < 0) return;
    if (hipMemsetAsync((char*)d_ws + WS_CTL, 0, 32 * 1024, stream) != hipSuccess) { fprintf(stderr, "kernel_launch: hipMemsetAsync failed\n"); return; }
    Args a{};
    for (int i = 0; i < 22; ++i) a.in[i] = (const float*)d_in[i];
    a.out = (float*)d_out; a.ws = (unsigned char*)d_ws; a.ph_lo = 0; a.ph_hi = 8;
    void* args[] = {&a};
    hipError_t e = hipLaunchCooperativeKernel((const void*)mk, dim3(grid), dim3(512), args, LDS_BYTES, stream);
    if (e != hipSuccess) fprintf(stderr, "kernel_launch: cooperative launch failed: %s (grid %d)\n", hipGetErrorString(e), grid);
}
```
